# Optimizing an MI355X kernel written in HIP

```python
import jax
import jax.numpy as jnp
from jax import lax
import numpy as np


D_MODEL = 1024
BATCH = 16
SEQ = 4096
DEPTH = 1

ATT_HEADS = 8
ATT_KV_HEADS = 2
ATT_HEAD_DIM = 64
ATT_GROUP = ATT_HEADS // ATT_KV_HEADS
ATT_WIDTH = ATT_HEADS * ATT_HEAD_DIM
ATT_KV_WIDTH = ATT_KV_HEADS * ATT_HEAD_DIM
WINDOW = 128
ATT_BLOCK = 128
DN_HEADS = 4
DN_HEAD_DIM = 128
DN_WIDTH = DN_HEADS * DN_HEAD_DIM
CONV_WIDTH = 4
DN_CHUNK = 64
D_MIX = ATT_WIDTH + DN_WIDTH
IN_SPLITS = (ATT_WIDTH, ATT_KV_WIDTH, ATT_KV_WIDTH, 3 * DN_WIDTH, DN_HEADS, DN_HEADS, DN_WIDTH)
D_IN_PROJ = ATT_WIDTH + 2 * ATT_KV_WIDTH + 4 * DN_WIDTH + 2 * DN_HEADS
PEER_HEADS = 8
N_KEYS = 128
N_EXPERTS = N_KEYS * N_KEYS
PEER_QDIM = 128
PEER_HALF = PEER_QDIM // 2
PEER_TOPK = 16
PEER_TOKEN_BLOCK = 128
EPS = 1e-6

kernel_name = "hybrid_swa_sink_gdn_peer_block"


def rms_norm(x, g):
    xf = x.astype(jnp.float32)
    y = xf * lax.rsqrt(jnp.mean(xf * xf, axis=-1, keepdims=True) + EPS)
    return (y * g.astype(jnp.float32)).astype(x.dtype)


def l2norm(x):
    return x * lax.rsqrt(jnp.sum(x * x, axis=-1, keepdims=True) + EPS)


def sliding_window_sink_attention(q, k, v, sinks):
    B, S = q.shape[0], q.shape[1]
    nb = S // ATT_BLOCK
    f32 = jnp.float32
    qb = q.reshape(B, nb, ATT_BLOCK, ATT_KV_HEADS, ATT_GROUP, ATT_HEAD_DIM).astype(f32)

    def band(t):
        tb = t.reshape(B, nb, ATT_BLOCK, ATT_KV_HEADS, ATT_HEAD_DIM).astype(f32)
        prev = jnp.pad(tb[:, :-1], ((0, 0), (1, 0), (0, 0), (0, 0), (0, 0)))
        return jnp.concatenate([prev, tb], axis=2)

    kb, vb = band(k), band(v)
    s = jnp.einsum('bnqhgd,bnkhd->bnhgqk', qb, kb) * (ATT_HEAD_DIM ** -0.5)
    qi = jnp.arange(ATT_BLOCK)[:, None]
    kj = jnp.arange(2 * ATT_BLOCK)[None, :]
    rel = qi + ATT_BLOCK - kj
    in_window = (rel >= 0) & (rel < WINDOW)
    key_exists = (jnp.arange(nb)[:, None, None] > 0) | (kj[None] >= ATT_BLOCK)
    mask = in_window[None] & key_exists
    s = jnp.where(mask[None, :, None, None], s, -jnp.inf)
    sink = sinks.astype(f32).reshape(ATT_KV_HEADS, ATT_GROUP)[None, None, :, :, None, None]
    m = jnp.maximum(jnp.max(s, axis=-1, keepdims=True), sink)
    p = jnp.exp(s - m)
    denom = jnp.sum(p, axis=-1, keepdims=True) + jnp.exp(sink - m)
    o = jnp.einsum('bnhgqk,bnkhd->bnqhgd', p / denom, vb)
    return o.reshape(B, S, ATT_WIDTH)


def causal_conv_silu(x, w):
    S = x.shape[1]
    xp = jnp.pad(x, ((0, 0), (CONV_WIDTH - 1, 0), (0, 0)))
    y = sum(xp[:, j:j + S] * w[j] for j in range(CONV_WIDTH))
    return jax.nn.silu(y)


def gated_delta_rule(q, k, v, g, beta):
    B, S, H, D = q.shape
    C = DN_CHUNK
    nc = S // C
    f32 = jnp.float32

    def chunks(t):
        return t.reshape(B, nc, C, H, D).transpose(0, 3, 1, 2, 4)

    q, k, v = chunks(q), chunks(k), chunks(v)
    g = g.reshape(B, nc, C, H).transpose(0, 3, 1, 2)
    beta = beta.reshape(B, nc, C, H).transpose(0, 3, 1, 2)
    gc = jnp.cumsum(g, axis=-1)
    causal = jnp.tril(jnp.ones((C, C), dtype=bool))
    strict = jnp.tril(jnp.ones((C, C), dtype=bool), k=-1)
    diff = gc[..., :, None] - gc[..., None, :]
    decay_mat = jnp.where(causal, jnp.exp(jnp.where(causal, diff, 0.0)), 0.0)
    kb = k * beta[..., None]
    m_low = jnp.where(strict, jnp.einsum('bhncd,bhnjd->bhncj', kb, k) * decay_mat, 0.0)
    a_mat = m_low + jnp.eye(C, dtype=f32)
    rhs = jnp.concatenate([v * beta[..., None], kb * jnp.exp(gc)[..., None]], axis=-1)
    sol = lax.linalg.triangular_solve(a_mat, rhs, left_side=True, lower=True, unit_diagonal=True)
    u, w = sol[..., :D], sol[..., D:]
    qk = jnp.where(causal, jnp.einsum('bhncd,bhnjd->bhncj', q, k) * decay_mat, 0.0)
    q_dec = q * jnp.exp(gc)[..., None]
    k_dec = k * jnp.exp(gc[..., -1:] - gc)[..., None]
    chunk_decay = jnp.exp(gc[..., -1])

    def step(state, inp):
        u_c, w_c, qk_c, qd_c, kd_c, cd_c = inp
        v_new = u_c - jnp.einsum('bhcd,bhde->bhce', w_c, state)
        o_c = jnp.einsum('bhcd,bhde->bhce', qd_c, state) + jnp.einsum('bhcj,bhje->bhce', qk_c, v_new)
        state = state * cd_c[..., None, None] + jnp.einsum('bhcd,bhce->bhde', kd_c, v_new)
        return state, o_c

    xs = tuple(jnp.moveaxis(t, 2, 0) for t in (u, w, qk, q_dec, k_dec, chunk_decay))
    init = jnp.zeros((B, H, D, D), dtype=f32)
    _, o = lax.scan(step, init, xs)
    return o.transpose(1, 0, 3, 2, 4).reshape(B, S, H, D)


def peer(xn, w_q, sub_keys, u_tab, v_tab):
    B, S, D = xn.shape
    T = B * S
    xt = xn.reshape(T, D)
    q = (xt @ w_q).reshape(T, PEER_HEADS, 2, PEER_HALF)
    s = jnp.einsum('thpc,hpnc->thpn', q, sub_keys)
    s_top, i_top = lax.top_k(s, PEER_TOPK)
    cand_s = (s_top[:, :, 0, :, None] + s_top[:, :, 1, None, :]).reshape(T, PEER_HEADS, PEER_TOPK * PEER_TOPK)
    cand_i = (i_top[:, :, 0, :, None] * N_KEYS + i_top[:, :, 1, None, :]).reshape(T, PEER_HEADS, PEER_TOPK * PEER_TOPK)
    best_s, pos = lax.top_k(cand_s, PEER_TOPK)
    idx = jnp.take_along_axis(cand_i, pos, axis=-1)
    gate = jax.nn.softmax(best_s.astype(jnp.float32), axis=-1).astype(xn.dtype)
    nblk = T // PEER_TOKEN_BLOCK
    hk = PEER_HEADS * PEER_TOPK

    def block(args):
        xb, ib, gb = args
        act = jax.nn.gelu(jnp.einsum('tkd,td->tk', u_tab[ib], xb), approximate=False)
        return jnp.einsum('tk,tkd->td', act * gb, v_tab[ib])

    out = lax.map(block, (xt.reshape(nblk, PEER_TOKEN_BLOCK, D),
                          idx.reshape(nblk, PEER_TOKEN_BLOCK, hk),
                          gate.reshape(nblk, PEER_TOKEN_BLOCK, hk)))
    return out.reshape(B, S, D)


def hybrid_layer(h, norm_mix_g, w_in, att_q_norm_g, att_k_norm_g, att_sinks, att_out_norm_g,
                 dn_conv_w, dn_a_log, dn_dt_bias, dn_out_norm_g, w_out, norm_ffn_g,
                 peer_w_q, peer_sub_keys, peer_u, peer_v):
    B, S, _ = h.shape
    f32 = jnp.float32
    xn = rms_norm(h, norm_mix_g)
    proj = xn @ w_in
    offs = []
    acc = 0
    for width in IN_SPLITS[:-1]:
        acc += width
        offs.append(acc)
    q_a, k_a, v_a, qkv_d, a_d, b_d, z_d = jnp.split(proj, offs, axis=-1)

    q_a = rms_norm(q_a.reshape(B, S, ATT_HEADS, ATT_HEAD_DIM), att_q_norm_g)
    k_a = rms_norm(k_a.reshape(B, S, ATT_KV_HEADS, ATT_HEAD_DIM), att_k_norm_g)
    v_a = v_a.reshape(B, S, ATT_KV_HEADS, ATT_HEAD_DIM)
    att = sliding_window_sink_attention(q_a, k_a, v_a, att_sinks).astype(h.dtype)
    att = rms_norm(att, att_out_norm_g)

    qkv = causal_conv_silu(qkv_d.astype(f32), dn_conv_w.astype(f32))
    q_d, k_d, v_d = jnp.split(qkv, 3, axis=-1)
    shp = (B, S, DN_HEADS, DN_HEAD_DIM)
    q_d = l2norm(q_d.reshape(shp)) * (DN_HEAD_DIM ** -0.5)
    k_d = l2norm(k_d.reshape(shp))
    v_d = v_d.reshape(shp)
    g = -jnp.exp(dn_a_log.astype(f32)) * jax.nn.softplus(a_d.astype(f32) + dn_dt_bias.astype(f32))
    beta = jax.nn.sigmoid(b_d.astype(f32))
    o = gated_delta_rule(q_d, k_d, v_d, g, beta)
    o = rms_norm(o, dn_out_norm_g) * jax.nn.silu(z_d.astype(f32).reshape(shp))
    dn = o.reshape(B, S, DN_WIDTH).astype(h.dtype)

    h = h + jnp.concatenate([att, dn], axis=-1) @ w_out
    h = h + peer(rms_norm(h, norm_ffn_g), peer_w_q, peer_sub_keys, peer_u, peer_v)
    return h


def setup_inputs(seed: int = 0) -> dict:
    key = jax.random.key(seed)
    ks = jax.random.split(key, 20)
    L = DEPTH
    nrm = jax.random.normal
    dt = jnp.exp(jax.random.uniform(ks[9], (L, DN_HEADS), minval=jnp.log(1e-3), maxval=jnp.log(1e-1)))
    return {
        "x": nrm(ks[0], (BATCH, SEQ, D_MODEL), jnp.float32),
        "norm_mix_g": 1.0 + 0.02 * nrm(ks[1], (L, D_MODEL), jnp.float32),
        "w_in": nrm(ks[2], (L, D_MODEL, D_IN_PROJ), jnp.float32) * D_MODEL ** -0.5,
        "att_q_norm_g": 1.0 + 0.02 * nrm(ks[3], (L, ATT_HEAD_DIM), jnp.float32),
        "att_k_norm_g": 1.0 + 0.02 * nrm(ks[4], (L, ATT_HEAD_DIM), jnp.float32),
        "att_sinks": nrm(ks[5], (L, ATT_HEADS), jnp.float32),
        "att_out_norm_g": 1.0 + 0.02 * nrm(ks[6], (L, ATT_WIDTH), jnp.float32),
        "dn_conv_w": nrm(ks[7], (L, CONV_WIDTH, 3 * DN_WIDTH), jnp.float32) * CONV_WIDTH ** -0.5,
        "dn_a_log": jnp.log(jax.random.uniform(ks[8], (L, DN_HEADS), minval=1.0, maxval=16.0)),
        "dn_dt_bias": dt + jnp.log(-jnp.expm1(-dt)),
        "dn_out_norm_g": 1.0 + 0.02 * nrm(ks[10], (L, DN_HEAD_DIM), jnp.float32),
        "w_out": nrm(ks[11], (L, D_MIX, D_MODEL), jnp.float32) * D_MIX ** -0.5,
        "norm_ffn_g": 1.0 + 0.02 * nrm(ks[12], (L, D_MODEL), jnp.float32),
        "peer_w_q": nrm(ks[13], (L, D_MODEL, PEER_HEADS * PEER_QDIM), jnp.float32) * D_MODEL ** -0.5,
        "peer_sub_keys": nrm(ks[14], (L, PEER_HEADS, 2, N_KEYS, PEER_HALF), jnp.float32) * PEER_HALF ** -0.5,
        "peer_u": nrm(ks[15], (L, N_EXPERTS, D_MODEL), jnp.float32) * D_MODEL ** -0.5,
        "peer_v": nrm(ks[16], (L, N_EXPERTS, D_MODEL), jnp.float32) * D_MODEL ** -0.5,
    }


def reference(x, norm_mix_g, w_in, att_q_norm_g, att_k_norm_g, att_sinks, att_out_norm_g,
              dn_conv_w, dn_a_log, dn_dt_bias, dn_out_norm_g, w_out, norm_ffn_g,
              peer_w_q, peer_sub_keys, peer_u, peer_v):
    h = x
    for l in range(DEPTH):
        h = hybrid_layer(h, norm_mix_g[l], w_in[l], att_q_norm_g[l], att_k_norm_g[l], att_sinks[l],
                         att_out_norm_g[l], dn_conv_w[l], dn_a_log[l], dn_dt_bias[l], dn_out_norm_g[l],
                         w_out[l], norm_ffn_g[l], peer_w_q[l], peer_sub_keys[l], peer_u[l], peer_v[l])
    return h
```

```cpp
#include <hip/hip_runtime.h>
#include <hip/hip_cooperative_groups.h>
#include <cstdio>
namespace cg = cooperative_groups;

#define DI __device__ __forceinline__
typedef unsigned short u16;
typedef __attribute__((ext_vector_type(8))) short bf16x8;
typedef __attribute__((ext_vector_type(4))) float f32x4;
typedef __attribute__((ext_vector_type(4))) unsigned u32x4;
typedef __attribute__((ext_vector_type(2))) unsigned u32x2;

constexpr int T = 65536;
constexpr int NP = 2816;
constexpr int SMEM_BYTES = 75776;
constexpr float EPS = 1e-6f;

struct Params {
  const float *x, *g1, *w_in, *gq, *gk, *sinks, *g_att, *convw, *a_log, *dt_bias, *g_o, *w_out, *g_ffn, *w_q, *keys, *pu, *pv;
  float* out;
  char* ws;
};
constexpr size_t MiB = 1024 * 1024;
constexpr size_t OFF_mixA = 0, OFF_proj = 128 * MiB, OFF_u_ = 480 * MiB, OFF_w_ = 544 * MiB, OFF_qd = 608 * MiB, OFF_kdT = 672 * MiB,
                 OFF_qk = 736 * MiB, OFF_ub = 768 * MiB, OFF_vb = 800 * MiB, OFF_WinT = 832 * MiB, OFF_WoutT = 838 * MiB, OFF_WqT = 840 * MiB,
                 OFF_keysb = 842 * MiB, OFF_pgate = 843 * MiB, OFF_rstd1 = 875 * MiB, OFF_rstd_att = 876 * MiB, OFF_rstd2 = 876 * MiB + 524288, OFF_gate_g = 877 * MiB,
                 OFF_gate_b = 878 * MiB, OFF_cd = 879 * MiB, OFF_bar = 879 * MiB + 32768, OFF_us = 879 * MiB + 65536, OFF_vs = 879 * MiB + 131072, WS_TOTAL = 880 * MiB;
constexpr size_t OFF_hb = OFF_u_, OFF_qp = OFF_qd, OFF_pidx = OFF_qk;
#define WSP(type, name) ((type*)(p.ws + OFF_##name))

DI int opaque_tid() { int t = threadIdx.x; asm volatile("" : "+v"(t)); return t; }
DI void lds_barrier() { asm volatile("s_waitcnt lgkmcnt(0)\n\ts_barrier" ::: "memory"); }
DI u32x4 mk4(unsigned a, unsigned b, unsigned c, unsigned d) { u32x4 r = {a, b, c, d}; return r; }
DI u32x2 mk2(unsigned a, unsigned b) { u32x2 r = {a, b}; return r; }
DI f32x4 mkf4(float a, float b, float c, float d) { f32x4 r = {a, b, c, d}; return r; }
typedef __bf16 bf16x2_t __attribute__((ext_vector_type(2)));
DI u16 f2bf(float f) { __bf16 v = (__bf16)f; return __builtin_bit_cast(u16, v); }
DI float bf2f(u16 h) { return __uint_as_float(((unsigned)h) << 16); }
DI unsigned pk(float a, float b) { bf16x2_t v = {(__bf16)a, (__bf16)b}; return __builtin_bit_cast(unsigned, v); }
DI float bflo(unsigned u) { return __uint_as_float(u << 16); }
DI float bfhi(unsigned u) { return __uint_as_float(u & 0xffff0000u); }
DI f32x4 mfma16(bf16x8 a, bf16x8 b, f32x4 c) { return __builtin_amdgcn_mfma_f32_16x16x32_bf16(a, b, c, 0, 0, 0); }
DI float wsum(float v) {
#pragma unroll
  for (int o = 32; o > 0; o >>= 1) v += __shfl_xor(v, o);
  return v;
}
DI void unpack8(u32x4 v, float* f) {
  f[0] = bflo(v.x); f[1] = bfhi(v.x); f[2] = bflo(v.y); f[3] = bfhi(v.y);
  f[4] = bflo(v.z); f[5] = bfhi(v.z); f[6] = bflo(v.w); f[7] = bfhi(v.w);
}
DI u32x4 pack8(const float* f) { return mk4(pk(f[0], f[1]), pk(f[2], f[3]), pk(f[4], f[5]), pk(f[6], f[7])); }
DI bf16x8 as_frag(u32x4 v) { return __builtin_bit_cast(bf16x8, v); }
DI u32x2 pack4(f32x4 v) { return mk2(pk(v[0], v[1]), pk(v[2], v[3])); }
DI f32x4 fzero() { f32x4 z = {0.f, 0.f, 0.f, 0.f}; return z; }

DI void transpose_tile(const float* __restrict__ src, int ld, int col0, const float* __restrict__ scale, u16* __restrict__ dst,
                       int kt, int nt, float* tl) {
  const int tid = threadIdx.x;
  __syncthreads();
  float tv[16];
#pragma unroll
  for (int i = 0; i < 16; ++i) {
    int r = i * 4 + (tid >> 6), c = tid & 63;
    int k = kt * 64 + r;
    float s = scale ? scale[k] : 1.f;
    tv[i] = src[(size_t)k * ld + col0 + c] * s;
  }
#pragma unroll
  for (int i = 0; i < 16; ++i) { int r = i * 4 + (tid >> 6), c = tid & 63; tl[r * 65 + c] = tv[i]; }
  __syncthreads();
#pragma unroll 4
  for (int i = 0; i < 16; ++i) {
    int n = i * 4 + (tid >> 6), k = tid & 63;
    const int ng = nt * 64 + n, kg = kt * 64 + k;
    dst[((size_t)((ng >> 4) * 32 + (kg >> 5)) * 64 + ((kg >> 3) & 3) * 16 + (ng & 15)) * 8 + (kg & 7)] = f2bf(tl[k * 65 + n]);
  }
}

DI void phase0(const Params& p, char* smem) {
  const int tid = opaque_tid(), lane = tid & 63, wv = tid >> 6;
  {
    float* tl = (float*)smem;
    for (int tile = blockIdx.x; tile < 1216; tile += gridDim.x) {
      if (tile < 704) {
        int kt = tile / 44, nt = tile % 44;
        int n0 = nt * 64;
        int col0 = (n0 < 2304) ? n0 : n0 + 8;
        transpose_tile(p.w_in, 2824, col0, p.g1, WSP(u16, WinT), kt, nt, tl);
      } else if (tile < 960) {
        int t2 = tile - 704; int kt = t2 >> 4, nt = t2 & 15;
        transpose_tile(p.w_out, 1024, nt * 64, (kt < 8) ? p.g_att : nullptr, WSP(u16, WoutT), kt, nt, tl);
      } else {
        int t2 = tile - 960; int kt = t2 >> 4, nt = t2 & 15;
        transpose_tile(p.w_q, 1024, nt * 64, p.g_ffn, WSP(u16, WqT), kt, nt, tl);
      }
    }
    __syncthreads();
  }
  {
    const int gw = blockIdx.x * 4 + wv, nw = gridDim.x * 4;
    f32x4 v[4], vn[4];
    if (gw < 32768) {
      const f32x4* src = (const f32x4*)(((gw < 16384) ? p.pu : p.pv) + (size_t)(gw & 16383) * 1024);
#pragma unroll
      for (int i = 0; i < 4; ++i) v[i] = src[lane * 4 + i];
    }
    for (int row = gw; row < 32768; row += nw) {
      const bool isu = row < 16384;
      const int e = row & 16383;
      {
        const int rn = min(row + nw, 32767);
        const f32x4* srcn = (const f32x4*)(((rn < 16384) ? p.pu : p.pv) + (size_t)(rn & 16383) * 1024);
#pragma unroll
        for (int i = 0; i < 4; ++i) vn[i] = srcn[lane * 4 + i];
      }
#pragma unroll
      for (int i = 0; i < 4; ++i) {
        if (isu) { f32x4 g = ((const f32x4*)p.g_ffn)[lane * 4 + i]; v[i] *= g; }
      }
      float mx = 0.f;
#pragma unroll
      for (int i = 0; i < 4; ++i) mx = fmaxf(mx, fmaxf(fmaxf(fabsf(v[i].x), fabsf(v[i].y)), fmaxf(fabsf(v[i].z), fabsf(v[i].w))));
#pragma unroll
      for (int o = 32; o > 0; o >>= 1) mx = fmaxf(mx, __shfl_xor(mx, o));
      mx = fmaxf(mx, 1e-30f);
      const float inv = 127.f / mx;
      unsigned w[4];
#pragma unroll
      for (int i = 0; i < 4; ++i) {
        const float ofs = isu ? 0.f : 128.f;
        unsigned b0 = (unsigned)(int)(rintf(v[i].x * inv) + ofs) & 0xffu, b1 = (unsigned)(int)(rintf(v[i].y * inv) + ofs) & 0xffu;
        unsigned b2 = (unsigned)(int)(rintf(v[i].z * inv) + ofs) & 0xffu, b3 = (unsigned)(int)(rintf(v[i].w * inv) + ofs) & 0xffu;
        w[i] = b0 | (b1 << 8) | (b2 << 16) | (b3 << 24);
      }
      u32x4* dst = (u32x4*)(p.ws + OFF_ub) + (size_t)e * 128 + (isu ? 0 : 64) + lane;
      *dst = mk4(w[0], w[1], w[2], w[3]);
      if (lane == 0) ((float*)(p.ws + (isu ? OFF_us : OFF_vs)))[e] = mx * (1.f / 127.f);
#pragma unroll
      for (int i = 0; i < 4; ++i) v[i] = vn[i];
    }
    const size_t gtid = (size_t)blockIdx.x * 256 + tid, gsz = (size_t)gridDim.x * 256;
    for (size_t i = gtid; i < 131072 / 4; i += gsz) {
      f32x4 a = ((const f32x4*)p.keys)[i];
      ((u32x2*)WSP(u16, keysb))[i] = mk2(pk(a.x, a.y), pk(a.z, a.w));
    }
  }
  {
    float* wg = (float*)smem;
    {
      float tmp[32];
#pragma unroll
      for (int r = 0; r < 32; ++r) { int i = tid + 256 * r; int k = i >> 3, j = i & 7; tmp[r] = p.g1[k] * p.w_in[(size_t)k * 2824 + 2304 + j]; }
#pragma unroll
      for (int r = 0; r < 32; ++r) { int i = tid + 256 * r; int k = i >> 3, j = i & 7; wg[j * 1024 + k] = tmp[r]; }
    }
    __syncthreads();
    const int gw = blockIdx.x * 4 + wv, nw = gridDim.x * 4;
    auto xload = [&](int row, f32x4* v) {
      const int rc = min(row, T - 1);
#pragma unroll
      for (int i = 0; i < 4; ++i) v[i] = ((const f32x4*)(p.x + (size_t)rc * 1024))[lane + 64 * i];
    };
    auto xrow = [&](int row, const f32x4* v) {
      float ss = 0.f; float ga[8];
#pragma unroll
      for (int j = 0; j < 8; ++j) ga[j] = 0.f;
#pragma unroll
      for (int i = 0; i < 4; ++i) {
        ss += v[i].x * v[i].x + v[i].y * v[i].y + v[i].z * v[i].z + v[i].w * v[i].w;
#pragma unroll
        for (int j = 0; j < 8; ++j) {
          f32x4 w = ((const f32x4*)(wg + j * 1024))[lane + 64 * i];
          ga[j] += v[i].x * w.x + v[i].y * w.y + v[i].z * w.z + v[i].w * w.w;
        }
      }
      ss = wsum(ss);
      float mine;
      {
        const bool b0 = lane & 1, b1 = lane & 2, b2 = lane & 4;
        float k1[4], q1[2];
#pragma unroll
        for (int m = 0; m < 4; ++m) { float kp = b0 ? ga[2 * m + 1] : ga[2 * m], sd = b0 ? ga[2 * m] : ga[2 * m + 1]; k1[m] = kp + __shfl_xor(sd, 1); }
#pragma unroll
        for (int m = 0; m < 2; ++m) { float kp = b1 ? k1[2 * m + 1] : k1[2 * m], sd = b1 ? k1[2 * m] : k1[2 * m + 1]; q1[m] = kp + __shfl_xor(sd, 2); }
        mine = (b2 ? q1[1] : q1[0]) + __shfl_xor(b2 ? q1[0] : q1[1], 4);
        mine += __shfl_xor(mine, 8); mine += __shfl_xor(mine, 16); mine += __shfl_xor(mine, 32);
      }
      const float rstd = rsqrtf(ss * (1.f / 1024.f) + EPS);
      u32x2* xo = (u32x2*)(WSP(u16, mixA) + (size_t)row * 1024);
#pragma unroll
      for (int i = 0; i < 4; ++i) xo[lane + 64 * i] = mk2(pk(v[i].x, v[i].y), pk(v[i].z, v[i].w));
      if (lane == 0) WSP(float, rstd1)[row] = rstd;
      if (lane < 8) {
        float a = mine * rstd; int hh = lane & 3;
        if (lane < 4) {
          float xx = a + p.dt_bias[hh];
          float sp = (xx > 20.f) ? xx : log1pf(expf(xx));
          WSP(float, gate_g)[(size_t)row * 4 + hh] = -expf(p.a_log[hh]) * sp;
        } else {
          WSP(float, gate_b)[(size_t)row * 4 + hh] = 1.f / (1.f + expf(-a));
        }
      }
    };
    f32x4 va[4], vb[4], vc[4];
    xload(gw, va); xload(gw + nw, vb);
    for (int row = gw; row < T; row += 3 * nw) {
      xload(row + 2 * nw, vc);
      xrow(row, va);
      xload(row + 3 * nw, va);
      if (row + nw < T) xrow(row + nw, vb);
      xload(row + 4 * nw, vb);
      if (row + 2 * nw < T) xrow(row + 2 * nw, vc);
    }
  }
}

template <class Pre, class Epi>
DI void gemm_tile(const u16* __restrict__ A, const u16* __restrict__ Bt, char* smem, Pre&& pre, Epi&& epi) {
  u16* As = (u16*)smem;
  const int tid = opaque_tid(), lane = tid & 63, wv = tid >> 6, l15 = lane & 15, quad = lane >> 4;
  f32x4 acc[4][8];
#pragma unroll
  for (int i = 0; i < 4; ++i)
#pragma unroll
    for (int j = 0; j < 8; ++j) acc[i][j] = fzero();
  u32x4 pa[4];
  bf16x8 w0[2][4], w1[2][4];
  const int lr = tid >> 3, lc = tid & 7;
  const u16* Ag = A + (size_t)lr * 1024 + lc * 8;
  const u16* Wg = Bt + ((size_t)(wv * 4) * 32 * 64 + lane) * 8;
#define GEMM_WLOAD(W, KT)                                                                          \
  {                                                                                               \
    _Pragma("unroll") for (int kk = 0; kk < 2; ++kk)                                              \
      _Pragma("unroll") for (int ft = 0; ft < 4; ++ft) W[kk][ft] = *(const bf16x8*)(Wg + (size_t)((ft * 32 + (KT) * 2 + kk) * 64) * 8); \
  }
#define GEMM_ALOAD(KT)                                                                             \
  { _Pragma("unroll") for (int i = 0; i < 4; ++i) pa[i] = *(const u32x4*)(Ag + (size_t)i * 32 * 1024 + (KT) * 64); }
#define GEMM_STEP(WC, WN, KT)                                                                      \
  {                                                                                               \
    __syncthreads();                                                                              \
    _Pragma("unroll") for (int i = 0; i < 4; ++i) *(u32x4*)(As + (lr + 32 * i) * 64 + ((lc ^ (lr & 7)) * 8)) = pa[i]; \
    __syncthreads();                                                                              \
    GEMM_ALOAD(min((KT) + 1, 15))                                                                 \
    GEMM_WLOAD(WN, min((KT) + 1, 15))                                                             \
    _Pragma("unroll") for (int kk = 0; kk < 2; ++kk) {                                            \
      _Pragma("unroll") for (int th = 0; th < 2; ++th) {                                          \
        bf16x8 af[4];                                                                             \
        _Pragma("unroll") for (int tt = 0; tt < 4; ++tt) af[tt] = *(const bf16x8*)(As + ((th * 4 + tt) * 16 + l15) * 64 + (((kk * 4 + quad) ^ (l15 & 7)) * 8)); \
        _Pragma("unroll") for (int ft = 0; ft < 4; ++ft)                                          \
          _Pragma("unroll") for (int tt = 0; tt < 4; ++tt) acc[ft][th * 4 + tt] = mfma16(WC[kk][ft], af[tt], acc[ft][th * 4 + tt]); \
        __builtin_amdgcn_sched_barrier(0);                                                        \
      }                                                                                           \
    }                                                                                             \
  }
  GEMM_ALOAD(0)
  GEMM_WLOAD(w0, 0)
  for (int kt = 0; kt < 16; kt += 2) {
    GEMM_STEP(w0, w1, kt)
    GEMM_STEP(w1, w0, kt + 1)
  }
#undef GEMM_WLOAD
#undef GEMM_ALOAD
#undef GEMM_STEP
  const int et = opaque_tid();
  const int el = et & 63, ewv = et >> 6, el15 = el & 15, equad = el >> 4;
#pragma unroll
  for (int th = 0; th < 2; ++th) {
    f32x4 pv[4][4];
#pragma unroll
    for (int ft = 0; ft < 4; ++ft)
#pragma unroll
      for (int tt = 0; tt < 4; ++tt) pv[ft][tt] = pre(th * 4 + tt, ft, ewv, el15, equad);
#pragma unroll
    for (int ft = 0; ft < 4; ++ft)
#pragma unroll
      for (int tt = 0; tt < 4; ++tt) epi(th * 4 + tt, ft, acc[ft][th * 4 + tt], pv[ft][tt], ewv, el15, equad);
    __builtin_amdgcn_sched_barrier(0);
  }
}

DI void phase1(const Params& p, char* smem) {
  const int tid_ = opaque_tid(); const int lane = tid_ & 63, wv = tid_ >> 6, l15 = lane & 15, quad = lane >> 4;
  const bool xcd_order = (gridDim.x & 7) == 0;
  const int xcd = blockIdx.x & 7, jb = blockIdx.x >> 3, nxb = gridDim.x >> 3;
  for (int it = xcd_order ? jb : (int)blockIdx.x; it < (xcd_order ? 704 : 5632); it += (xcd_order ? nxb : (int)gridDim.x)) {
    int mt, nt;
    if (xcd_order) {
      if (it < 640) { int np = it >> 7, r = it & 127; mt = xcd * 64 + (r >> 1); nt = 2 * np + (r & 1); }
      else { mt = xcd * 64 + (it - 640); nt = 10; }
    } else { mt = it / 11; nt = it % 11; }
    gemm_tile(WSP(u16, mixA) + (size_t)mt * 128 * 1024, WSP(u16, WinT) + (size_t)nt * 256 * 1024, smem,
      [&](int tt, int ft, int wv, int l15, int quad) { return mkf4(WSP(float, rstd1)[(size_t)mt * 128 + tt * 16 + l15], 0.f, 0.f, 0.f); },
      [&](int tt, int ft, f32x4 v, f32x4 pvv, int wv, int l15, int quad) {
      size_t t = (size_t)mt * 128 + tt * 16 + l15; int n = nt * 256 + wv * 64 + ft * 16 + quad * 4;
      float r = pvv[0];
      v[0] *= r; v[1] *= r; v[2] *= r; v[3] *= r;
      *(u32x2*)(WSP(u16, proj) + t * NP + n) = pack4(v);
    });
  }
}

DI void attn_item(const Params& p, int item, char* smem) {
  const int b = item >> 5, nb = item & 31;
  u16* Ks = (u16*)smem;
  u16* Vt = Ks + 256 * 72;
  const int tid = opaque_tid(), lane = tid & 63, wv = tid >> 6, l15 = lane & 15, quad = lane >> 4;
  const size_t tq0 = (size_t)b * 4096 + (size_t)nb * 128;
  float ssq0 = 0.f, ssq1 = 0.f;
  u32x4 qr0, qr1, qn0, qn1;
  {
    const u16* row = WSP(u16, proj) + (tq0 + wv * 32 + l15) * NP;
    qr0 = *(const u32x4*)(row + quad * 8); qr1 = *(const u32x4*)(row + 32 + quad * 8);
  }
#pragma unroll 1
  for (int it = 0; it < 16; ++it) {
    const int h = it >> 1, qt = it & 1, kvh = h >> 2;
    if ((it & 7) == 0) {
      __syncthreads();
      u32x4 kr[8], vr[8];
#pragma unroll
      for (int i = 0; i < 8; ++i) {
        int ch = tid + 256 * i; int kj = ch >> 3, c = ch & 7;
        int pos = max(nb * 128 - 128 + kj, 0);
        const u16* row = WSP(u16, proj) + ((size_t)b * 4096 + pos) * NP;
        kr[i] = *(const u32x4*)(row + 512 + kvh * 64 + c * 8);
        vr[i] = *(const u32x4*)(row + 640 + kvh * 64 + c * 8);
      }
#pragma unroll
      for (int i = 0; i < 8; ++i) {
        int ch = tid + 256 * i; int kj = ch >> 3, c = ch & 7;
        const bool valid = (nb * 128 - 128 + kj) >= 0;
        float kf[8]; unpack8(kr[i], kf);
        float s = 0.f;
#pragma unroll
        for (int e = 0; e < 8; ++e) s += kf[e] * kf[e];
        s += __shfl_xor(s, 1); s += __shfl_xor(s, 2); s += __shfl_xor(s, 4);
        float r = valid ? rsqrtf(s * (1.f / 64.f) + EPS) : 0.f;
#pragma unroll
        for (int e = 0; e < 8; ++e) kf[e] = kf[e] * r * p.gk[c * 8 + e];
        *(u32x4*)(Ks + kj * 72 + c * 8) = pack8(kf);
#pragma unroll
        for (int e = 0; e < 4; ++e) {
          unsigned wd = valid ? vr[i][e] : 0u;
          Vt[(c * 8 + 2 * e) * 264 + kj] = (u16)(wd & 0xffffu); Vt[(c * 8 + 2 * e + 1) * 264 + kj] = (u16)(wd >> 16);
        }
      }
      __syncthreads();
    }
    {
      const int itn = min(it + 1, 15);
      const u16* row = WSP(u16, proj) + (tq0 + wv * 32 + (itn & 1) * 16 + l15) * NP + (itn >> 1) * 64;
      qn0 = *(const u32x4*)(row + quad * 8); qn1 = *(const u32x4*)(row + 32 + quad * 8);
    }
    {
      const float sink = p.sinks[h];
      const int qi = wv * 32 + qt * 16 + l15;
      bf16x8 qf0, qf1;
      {
        float f0[8], f1[8]; unpack8(qr0, f0); unpack8(qr1, f1);
        float s = 0.f;
#pragma unroll
        for (int e = 0; e < 8; ++e) s += f0[e] * f0[e] + f1[e] * f1[e];
        s += __shfl_xor(s, 16); s += __shfl_xor(s, 32);
        float r = rsqrtf(s * (1.f / 64.f) + EPS) * 0.125f;
#pragma unroll
        for (int e = 0; e < 8; ++e) { f0[e] *= r * p.gq[quad * 8 + e]; f1[e] *= r * p.gq[32 + quad * 8 + e]; }
        qf0 = as_frag(pack8(f0)); qf1 = as_frag(pack8(f1));
      }
      f32x4 S[10];
#pragma unroll
      for (int i = 0; i < 10; ++i) {
        int kj0 = (2 * wv + i) * 16;
        bf16x8 k0 = *(const bf16x8*)(Ks + (kj0 + l15) * 72 + quad * 8);
        bf16x8 k1 = *(const bf16x8*)(Ks + (kj0 + l15) * 72 + 32 + quad * 8);
        f32x4 a = fzero();
        a = mfma16(k0, qf0, a);
        a = mfma16(k1, qf1, a);
        S[i] = a;
        if (i & 1) __builtin_amdgcn_sched_barrier(0);
      }
      float mx = -INFINITY;
#pragma unroll
      for (int i = 0; i < 10; ++i) {
        const bool interior = (i >= qt + 1) && (i <= qt + 7) && (nb > 0);
        if (interior) {
#pragma unroll
          for (int r = 0; r < 4; ++r) mx = fmaxf(mx, S[i][r]);
        } else {
#pragma unroll
          for (int r = 0; r < 4; ++r) {
            int kj = (2 * wv + i) * 16 + quad * 4 + r;
            int rel = qi + 128 - kj;
            bool ok = (rel >= 0) && (rel < 128) && (nb > 0 || kj >= 128);
            float s = ok ? S[i][r] : -INFINITY;
            S[i][r] = s; mx = fmaxf(mx, s);
          }
        }
      }
      mx = fmaxf(mx, __shfl_xor(mx, 16)); mx = fmaxf(mx, __shfl_xor(mx, 32));
      const float m = fmaxf(mx, sink);
      float sum = 0.f;
#pragma unroll
      for (int i = 0; i < 10; ++i)
#pragma unroll
        for (int r = 0; r < 4; ++r) { float pv = __expf(S[i][r] - m); S[i][r] = pv; sum += pv; }
      sum += __shfl_xor(sum, 16); sum += __shfl_xor(sum, 32);
      const float inv = 1.f / (sum + __expf(sink - m));
      f32x4 O[4];
#pragma unroll
      for (int dt = 0; dt < 4; ++dt) O[dt] = fzero();
#pragma unroll
      for (int ip = 0; ip < 5; ++ip) {
        const int kja = (2 * wv + 2 * ip) * 16 + quad * 4, kjb = kja + 16;
        f32x4 a = S[2 * ip], c = S[2 * ip + 1];
        bf16x8 pf = as_frag(mk4(pk(a[0], a[1]), pk(a[2], a[3]), pk(c[0], c[1]), pk(c[2], c[3])));
#pragma unroll
        for (int dt = 0; dt < 4; ++dt) {
          int d = dt * 16 + l15;
          u32x2 va = *(const u32x2*)(Vt + d * 264 + kja), vb2 = *(const u32x2*)(Vt + d * 264 + kjb);
          bf16x8 vf = as_frag(mk4(va.x, va.y, vb2.x, vb2.y));
          O[dt] = mfma16(vf, pf, O[dt]);
        }
        __builtin_amdgcn_sched_barrier(0);
      }
      float sq = 0.f;
      const size_t t = tq0 + qi;
#pragma unroll
      for (int dt = 0; dt < 4; ++dt) {
        f32x4 o = O[dt];
        o[0] *= inv; o[1] *= inv; o[2] *= inv; o[3] *= inv;
        sq += o[0] * o[0] + o[1] * o[1] + o[2] * o[2] + o[3] * o[3];
        *(u32x2*)(WSP(u16, mixA) + t * 1024 + h * 64 + dt * 16 + quad * 4) = pack4(o);
      }
      ssq0 += (qt == 0) ? sq : 0.f; ssq1 += (qt == 0) ? 0.f : sq;
    }
    qr0 = qn0; qr1 = qn1;
  }
  {
    float s = ssq0;
    s += __shfl_xor(s, 16); s += __shfl_xor(s, 32);
    const float r0 = rsqrtf(s * (1.f / 512.f) + EPS);
    s = ssq1;
    s += __shfl_xor(s, 16); s += __shfl_xor(s, 32);
    const float r1 = rsqrtf(s * (1.f / 512.f) + EPS);
#pragma unroll 1
    for (int hb2 = 0; hb2 < 2; ++hb2) {
      u32x2 pc[32];
#pragma unroll
      for (int j = 0; j < 32; ++j) {
        const int h = hb2 * 4 + (j >> 3), qt = (j >> 2) & 1, dt = j & 3;
        pc[j] = *(const u32x2*)(WSP(u16, mixA) + (tq0 + wv * 32 + qt * 16 + l15) * 1024 + h * 64 + dt * 16 + quad * 4);
      }
#pragma unroll
      for (int j = 0; j < 32; ++j) {
        const int h = hb2 * 4 + (j >> 3), qt = (j >> 2) & 1, dt = j & 3;
        const float r = qt ? r1 : r0;
        f32x4 o = mkf4(bflo(pc[j].x) * r, bfhi(pc[j].x) * r, bflo(pc[j].y) * r, bfhi(pc[j].y) * r);
        *(u32x2*)(WSP(u16, mixA) + (tq0 + wv * 32 + qt * 16 + l15) * 1024 + h * 64 + dt * 16 + quad * 4) = pack4(o);
      }
    }
  }
}

DI void dn_conv_load(const Params& p, int type, int h, int c, size_t t0, int tid, u32x4* raw) {
  const int rg = tid >> 4, cg = tid & 15;
  const u16* base = WSP(u16, proj) + 768 + type * 512 + h * 128 + cg * 8;
#pragma unroll
  for (int j = 0; j < 7; ++j) {
    int row = 4 * rg - 3 + j;
    int srow = c * 64 + row;
    size_t t = (srow >= 0) ? (size_t)((long)t0 + row) : t0;
    raw[j] = *(const u32x4*)(base + t * NP);
  }
}
DI void dn_conv_compute(const Params& p, int type, int h, int c, int tid, const u32x4* raw, float* F) {
  const int rg = tid >> 4, cg = tid & 15;
  const int ch = type * 512 + h * 128 + cg * 8;
  float w[4][8];
#pragma unroll
  for (int j = 0; j < 4; ++j) {
    f32x4 a = *(const f32x4*)(p.convw + j * 1536 + ch), b = *(const f32x4*)(p.convw + j * 1536 + ch + 4);
    w[j][0] = a.x; w[j][1] = a.y; w[j][2] = a.z; w[j][3] = a.w; w[j][4] = b.x; w[j][5] = b.y; w[j][6] = b.z; w[j][7] = b.w;
  }
  float x[7][8];
#pragma unroll
  for (int j = 0; j < 7; ++j) {
    unpack8(raw[j], x[j]);
    if (c * 64 + 4 * rg - 3 + j < 0) {
#pragma unroll
      for (int e = 0; e < 8; ++e) x[j][e] = 0.f;
    }
  }
#pragma unroll
  for (int r = 0; r < 4; ++r) {
    float y[8];
#pragma unroll
    for (int e = 0; e < 8; ++e) {
      float v = w[0][e] * x[r][e] + w[1][e] * x[r + 1][e] + w[2][e] * x[r + 2][e] + w[3][e] * x[r + 3][e];
      y[e] = v / (1.f + __expf(-v));
    }
    float* dst = F + (4 * rg + r) * 128 + cg * 8;
    *(f32x4*)dst = mkf4(y[0], y[1], y[2], y[3]);
    *(f32x4*)(dst + 4) = mkf4(y[4], y[5], y[6], y[7]);
  }
}
DI void dn_rownorm(const float* F, float* rn) {
  const int tid = opaque_tid();
  const int cc = tid >> 2, part = tid & 3;
  float s = 0.f;
#pragma unroll 8
  for (int i = 0; i < 32; ++i) { float v = F[cc * 128 + part * 32 + ((i + tid) & 31)]; s += v * v; }
  s += __shfl_xor(s, 1); s += __shfl_xor(s, 2);
  if (part == 0) rn[cc] = rsqrtf(s + EPS);
}

DI void dn_chunk_item(const Params& p, int ci, char* smem) {
  const int c = ci & 63, h = (ci >> 6) & 3, b = ci >> 8;
  float* F = (float*)smem;
  u16* kbf = (u16*)(smem + 32768);
  u16* qbf = kbf + 64 * 136;
  float* gcs = (float*)(smem + 32768 + 2 * 17408);
  float* bet = gcs + 64; float* rn = gcs + 128;
  const int tid = opaque_tid(), lane = tid & 63, wv = tid >> 6, l15 = lane & 15, quad = lane >> 4;
  const size_t t0 = (size_t)b * 4096 + (size_t)c * 64;
  float sol[64];
  u32x4 rawk[7], rawq[7], rawv[7];
  dn_conv_load(p, 1, h, c, t0, tid, rawk);
  dn_conv_load(p, 0, h, c, t0, tid, rawq);
  dn_conv_load(p, 2, h, c, t0, tid, rawv);
  __syncthreads();
  if (tid < 64) {
    float g = WSP(float, gate_g)[(t0 + tid) * 4 + h];
#pragma unroll
    for (int o = 1; o < 64; o <<= 1) { float n = __shfl_up(g, o); if (lane >= o) g += n; }
    gcs[tid] = g; bet[tid] = WSP(float, gate_b)[(t0 + tid) * 4 + h]; gcs[192 + tid] = __expf(g);
  }
  dn_conv_compute(p, 1, h, c, tid, rawk, F);
  __syncthreads();
  dn_rownorm(F, rn);
  __syncthreads();
  {
    const int d = tid & 127, half = tid >> 7;
#pragma unroll 8
    for (int i = 0; i < 32; ++i) { int cc = half * 32 + i; kbf[cc * 136 + d] = f2bf(F[cc * 128 + d] * rn[cc]); }
    if (tid >= 128) {
#pragma unroll
      for (int cc = 0; cc < 64; ++cc) sol[cc] = F[cc * 128 + d] * rn[cc] * bet[cc] * gcs[192 + cc];
    }
  }
  __syncthreads();
  dn_conv_compute(p, 0, h, c, tid, rawq, F);
  __syncthreads();
  dn_rownorm(F, rn);
  __syncthreads();
  {
    const int d = tid & 127, half = tid >> 7;
#pragma unroll 8
    for (int i = 0; i < 32; ++i) { int cc = half * 32 + i; qbf[cc * 136 + d] = f2bf(F[cc * 128 + d] * rn[cc] * 0.08838834764831845f); }
  }
  __syncthreads();
  dn_conv_compute(p, 2, h, c, tid, rawv, F);
  __syncthreads();
  if (tid < 128) {
#pragma unroll
    for (int cc = 0; cc < 64; ++cc) sol[cc] = F[cc * 128 + tid] * bet[cc];
  }
  __syncthreads();
  float* Mf = F;
  {
    bf16x8 kc[4], qc[4];
#pragma unroll
    for (int kk = 0; kk < 4; ++kk) {
      kc[kk] = *(const bf16x8*)(kbf + (wv * 16 + l15) * 136 + kk * 32 + quad * 8);
      qc[kk] = *(const bf16x8*)(qbf + (wv * 16 + l15) * 136 + kk * 32 + quad * 8);
    }
    const int ci_ = wv * 16 + l15;
    const float gci = gcs[ci_], bi = bet[ci_];
#pragma unroll
    for (int jt = 0; jt < 4; ++jt) {
      f32x4 akk = fzero(), aqk = fzero();
#pragma unroll
      for (int kk = 0; kk < 4; ++kk) {
        bf16x8 kj = *(const bf16x8*)(kbf + (jt * 16 + l15) * 136 + kk * 32 + quad * 8);
        akk = mfma16(kj, kc[kk], akk);
        aqk = mfma16(kj, qc[kk], aqk);
      }
      f32x4 m4, q4;
#pragma unroll
      for (int r = 0; r < 4; ++r) {
        int j = jt * 16 + quad * 4 + r;
        float dec = __expf(fminf(gci - gcs[j], 0.f));
        m4[r] = (ci_ > j) ? bi * akk[r] * dec : 0.f;
        q4[r] = (ci_ >= j) ? aqk[r] * dec : 0.f;
      }
      *(f32x4*)(Mf + ci_ * 64 + jt * 16 + quad * 4) = mkf4(m4[0], m4[1], m4[2], m4[3]);
      *(u32x2*)(WSP(u16, qk) + ((size_t)ci * 64 + ci_) * 64 + jt * 16 + quad * 4) = pack4(q4);
    }
  }
  __syncthreads();
  {
    const int d = tid & 127, half = tid >> 7;
#pragma unroll 8
    for (int i = 0; i < 32; ++i) {
      int cc = half * 32 + i;
      WSP(u16, qd)[(size_t)ci * 8192 + cc * 128 + d] = f2bf(bf2f(qbf[cc * 136 + d]) * gcs[192 + cc]);
    }
    const int c2 = tid & 63, dg = tid >> 6;
    const float e = __expf(gcs[63] - gcs[c2]);
#pragma unroll 8
    for (int i = 0; i < 32; ++i) {
      int dd = dg * 32 + i;
      WSP(u16, kdT)[(size_t)ci * 8192 + dd * 64 + c2] = f2bf(bf2f(kbf[c2 * 136 + dd]) * e);
    }
    if (tid == 0) WSP(float, cd)[ci] = __expf(gcs[63]);
  }
  __syncthreads();
  {
    u16* Xt = (u16*)(smem + 32768);
    float* Cs = F + 4096;
    const int col = tid;
    {
      u32x4* z = (u32x4*)(Xt + col * 72);
#pragma unroll
      for (int i = 0; i < 9; ++i) z[i] = mk4(0u, 0u, 0u, 0u);
    }
#pragma unroll
    for (int bi = 0; bi < 4; ++bi) {
      float c16[16];
#pragma unroll
      for (int r = 0; r < 16; ++r) c16[r] = 0.f;
      if (bi > 0) {
        const int nks = (bi == 3) ? 2 : 1;
        bf16x8 af[2];
#pragma unroll
        for (int ks = 0; ks < 2; ++ks) {
          if (ks < nks) {
            const float* mp = Mf + (16 * bi + l15) * 64 + ks * 32 + quad * 8;
            f32x4 m0 = *(const f32x4*)mp, m1 = *(const f32x4*)(mp + 4);
            const bool keep = (ks * 32 + quad * 8) < 16 * bi;
            if (!keep) { m0 = fzero(); m1 = fzero(); }
            af[ks] = as_frag(mk4(pk(m0[0], m0[1]), pk(m0[2], m0[3]), pk(m1[0], m1[1]), pk(m1[2], m1[3])));
          }
        }
#pragma unroll
        for (int ct = 0; ct < 4; ++ct) {
          const int cb = (wv * 4 + ct) * 16 + l15;
          f32x4 a = fzero();
#pragma unroll
          for (int ks = 0; ks < 2; ++ks) {
            if (ks < nks) {
              bf16x8 xb = *(const bf16x8*)(Xt + cb * 72 + ks * 32 + quad * 8);
              a = mfma16(af[ks], xb, a);
            }
          }
          *(f32x4*)(Cs + cb * 16 + quad * 4) = a;
        }
        asm volatile("s_waitcnt lgkmcnt(0)" ::: "memory");
#pragma unroll
        for (int q = 0; q < 4; ++q) {
          f32x4 cv = *(const f32x4*)(Cs + col * 16 + q * 4);
          c16[4 * q] = cv[0]; c16[4 * q + 1] = cv[1]; c16[4 * q + 2] = cv[2]; c16[4 * q + 3] = cv[3];
        }
      }
#pragma unroll
      for (int r = 0; r < 16; ++r) {
        const int cc = 16 * bi + r;
        float a = sol[cc] - c16[r];
#pragma unroll
        for (int j4 = 4 * bi; j4 < (cc + 3) / 4; ++j4) {
          f32x4 m = *(const f32x4*)(Mf + cc * 64 + j4 * 4);
          a -= m.x * sol[j4 * 4] + m.y * sol[j4 * 4 + 1] + m.z * sol[j4 * 4 + 2] + m.w * sol[j4 * 4 + 3];
        }
        sol[cc] = a;
      }
      if (bi < 3) {
        u32x4* xo = (u32x4*)(Xt + col * 72 + 16 * bi);
        xo[0] = mk4(pk(sol[16 * bi], sol[16 * bi + 1]), pk(sol[16 * bi + 2], sol[16 * bi + 3]), pk(sol[16 * bi + 4], sol[16 * bi + 5]),
                    pk(sol[16 * bi + 6], sol[16 * bi + 7]));
        xo[1] = mk4(pk(sol[16 * bi + 8], sol[16 * bi + 9]), pk(sol[16 * bi + 10], sol[16 * bi + 11]), pk(sol[16 * bi + 12], sol[16 * bi + 13]),
                    pk(sol[16 * bi + 14], sol[16 * bi + 15]));
        asm volatile("s_waitcnt lgkmcnt(0)" ::: "memory");
      }
    }
  }
  {
    u16* dst = (u16*)(p.ws + ((tid < 128) ? OFF_u_ : OFF_w_)) + (size_t)ci * 8192 + (tid & 127);
#pragma unroll
    for (int cc = 0; cc < 64; ++cc) dst[cc * 128] = f2bf(sol[cc]);
  }
}

struct ScanFrag { bf16x8 wf[4], qf[4], qkf[2], kf[2][2]; u32x2 uu; float cdv; };

DI void scan_load(const Params& p, int bh, int s, int sl, ScanFrag& f) {
  const int tid_ = opaque_tid(); const int lane = tid_ & 63, wv = tid_ >> 6, l15 = lane & 15, quad = lane >> 4;
  const size_t ci = (size_t)bh * 64 + s;
  const u16* wb = WSP(u16, w_) + ci * 8192 + (wv * 16 + l15) * 128 + quad * 8;
  const u16* qb = WSP(u16, qd) + ci * 8192 + (wv * 16 + l15) * 128 + quad * 8;
#pragma unroll
  for (int kk = 0; kk < 4; ++kk) { f.wf[kk] = *(const bf16x8*)(wb + kk * 32); f.qf[kk] = *(const bf16x8*)(qb + kk * 32); }
  const u16* qkb = WSP(u16, qk) + ci * 4096 + (wv * 16 + l15) * 64 + quad * 8;
#pragma unroll
  for (int k2 = 0; k2 < 2; ++k2) f.qkf[k2] = *(const bf16x8*)(qkb + k2 * 32);
#pragma unroll
  for (int dt = 0; dt < 2; ++dt)
#pragma unroll
    for (int k2 = 0; k2 < 2; ++k2)
      f.kf[dt][k2] = *(const bf16x8*)(WSP(u16, kdT) + ci * 8192 + ((2 * wv + dt) * 16 + l15) * 64 + k2 * 32 + quad * 8);
  f.uu = *(const u32x2*)(WSP(u16, u_) + ci * 8192 + (wv * 16 + l15) * 128 + sl * 16 + quad * 4);
  f.cdv = WSP(float, cd)[ci];
}

DI void dn_scan_item(const Params& p, int item, char* smem) {
  const int bh = (item & 7) + 8 * (item >> 6), sl = (item >> 3) & 7;
  const int b = bh >> 2, h = bh & 3;
  u16* St = (u16*)smem;
  u16* vnT = St + 16 * 136;
  const int tid = opaque_tid(), lane = tid & 63, wv = tid >> 6, l15 = lane & 15, quad = lane >> 4;
  __syncthreads();
  for (int i = tid; i < 16 * 136; i += 256) St[i] = 0;
  f32x4 Sacc[2] = {fzero(), fzero()};
  ScanFrag fa, fb, fc;
  scan_load(p, bh, 0, sl, fa);
  scan_load(p, bh, 1, sl, fb);
  __syncthreads();
  auto step = [&](const ScanFrag& cur, int s) {
    bf16x8 sa[4];
#pragma unroll
    for (int kk = 0; kk < 4; ++kk) sa[kk] = *(const bf16x8*)(St + l15 * 136 + kk * 32 + quad * 8);
    f32x4 av = fzero(), ao = fzero();
#pragma unroll
    for (int kk = 0; kk < 4; ++kk) { av = mfma16(sa[kk], cur.wf[kk], av); ao = mfma16(sa[kk], cur.qf[kk], ao); }
    float vn[4];
    vn[0] = bflo(cur.uu.x) - av[0]; vn[1] = bfhi(cur.uu.x) - av[1];
    vn[2] = bflo(cur.uu.y) - av[2]; vn[3] = bfhi(cur.uu.y) - av[3];
#pragma unroll
    for (int r = 0; r < 4; ++r) vnT[(quad * 4 + r) * 72 + wv * 16 + l15] = f2bf(vn[r]);
    lds_barrier();
    bf16x8 va[2];
#pragma unroll
    for (int k2 = 0; k2 < 2; ++k2) va[k2] = *(const bf16x8*)(vnT + l15 * 72 + k2 * 32 + quad * 8);
#pragma unroll
    for (int k2 = 0; k2 < 2; ++k2) ao = mfma16(va[k2], cur.qkf[k2], ao);
    {
      size_t t = (size_t)b * 4096 + (size_t)s * 64 + wv * 16 + l15;
      *(u32x2*)(WSP(u16, mixA) + t * 1024 + 512 + h * 128 + sl * 16 + quad * 4) = pack4(ao);
    }
#pragma unroll
    for (int dt = 0; dt < 2; ++dt) {
      f32x4 sv = Sacc[dt];
      sv[0] *= cur.cdv; sv[1] *= cur.cdv; sv[2] *= cur.cdv; sv[3] *= cur.cdv;
#pragma unroll
      for (int k2 = 0; k2 < 2; ++k2) sv = mfma16(va[k2], cur.kf[dt][k2], sv);
      Sacc[dt] = sv;
#pragma unroll
      for (int r = 0; r < 4; ++r) St[(quad * 4 + r) * 136 + (2 * wv + dt) * 16 + l15] = f2bf(sv[r]);
    }
    lds_barrier();
  };
  for (int s = 0; s < 63; s += 3) {
    scan_load(p, bh, s + 2, sl, fc);
    step(fa, s);
    scan_load(p, bh, min(s + 3, 63), sl, fa);
    step(fb, s + 1);
    scan_load(p, bh, min(s + 4, 63), sl, fb);
    step(fc, s + 2);
  }
  step(fa, 63);
}

DI unsigned enc_f(float f) { unsigned u = __float_as_uint(f); return (u & 0x80000000u) ? ~u : (u | 0x80000000u); }
DI float dec_f(unsigned k) { unsigned u = (k & 0x80000000u) ? (k ^ 0x80000000u) : ~k; return __uint_as_float(u); }

DI void p4_gemm2(const Params& p, int tile, char* smem) {
  const int tid = opaque_tid(), lane = tid & 63, wv = tid >> 6, l15 = lane & 15, quad = lane >> 4;
  const size_t t0 = (size_t)tile * 128;
  float* ssq_l = (float*)(smem + 74752);
  __syncthreads();
  if (tid < 128) ssq_l[tid] = 0.f;
  for (int i0 = 0; i0 < 32; i0 += 4) {
    const int cc = tid & 63;
    u32x4 rd[4], rz[4];
#pragma unroll
    for (int i = 0; i < 4; ++i) {
      size_t t = t0 + (tid >> 6) + 4 * (i0 + i);
      rd[i] = *(const u32x4*)(WSP(u16, mixA) + t * 1024 + 512 + cc * 8);
      rz[i] = *(const u32x4*)(WSP(u16, proj) + t * NP + 2304 + cc * 8);
    }
#pragma unroll
    for (int i = 0; i < 4; ++i) {
      size_t t = t0 + (tid >> 6) + 4 * (i0 + i);
      float f[8], z[8];
      unpack8(rd[i], f); unpack8(rz[i], z);
      float sq = 0.f;
#pragma unroll
      for (int e = 0; e < 8; ++e) sq += f[e] * f[e];
#pragma unroll
      for (int m = 1; m < 16; m <<= 1) sq += __int_as_float(__builtin_amdgcn_ds_bpermute((cc ^ m) << 2, __float_as_int(sq)));
      float r = rsqrtf(sq * (1.f / 128.f) + EPS);
#pragma unroll
      for (int e = 0; e < 8; ++e) f[e] = f[e] * r * p.g_o[(cc & 15) * 8 + e] * (z[e] / (1.f + __expf(-z[e])));
      *(u32x4*)(WSP(u16, mixA) + t * 1024 + 512 + cc * 8) = pack8(f);
    }
  }
  __syncthreads();
  {
    for (int nc = 0; nc < 4; ++nc) {
      float ssq[8] = {0.f, 0.f, 0.f, 0.f, 0.f, 0.f, 0.f, 0.f};
      gemm_tile(WSP(u16, mixA) + t0 * 1024, WSP(u16, WoutT) + (size_t)nc * 256 * 1024, smem,
        [&](int tt, int ft, int wv, int l15, int quad) {
        size_t t = t0 + tt * 16 + l15; int n = nc * 256 + wv * 64 + ft * 16 + quad * 4;
        return *(const f32x4*)(p.x + t * 1024 + n);
      },
        [&](int tt, int ft, f32x4 v, f32x4 xv, int wv, int l15, int quad) {
        size_t t = t0 + tt * 16 + l15; int n = nc * 256 + wv * 64 + ft * 16 + quad * 4;
        f32x4 hv = xv + v;
        *(u32x2*)(WSP(u16, hb) + t * 1024 + n) = pack4(hv);
        ssq[tt] += hv[0] * hv[0] + hv[1] * hv[1] + hv[2] * hv[2] + hv[3] * hv[3];
      });
      {
        const int t2 = opaque_tid(); const int ln = t2 & 63, l15b = ln & 15, qdb = ln >> 4;
#pragma unroll
        for (int tt = 0; tt < 8; ++tt) {
          float sv = ssq[tt];
          sv += __int_as_float(__builtin_amdgcn_ds_bpermute((ln ^ 16) << 2, __float_as_int(sv)));
          sv += __int_as_float(__builtin_amdgcn_ds_bpermute((ln ^ 32) << 2, __float_as_int(sv)));
          if (qdb == 0) atomicAdd(&ssq_l[tt * 16 + l15b], sv);
        }
      }
    }
  }
  __syncthreads();
  {
    const int t3 = opaque_tid();
    if (t3 < 128) WSP(float, rstd2)[t0 + t3] = rsqrtf(ssq_l[t3] * (1.f / 1024.f) + EPS);
  }
}

DI void p4_gemm3(const Params& p, int tile, char* smem) {
  const int tid = opaque_tid(), lane = tid & 63, wv = tid >> 6, l15 = lane & 15, quad = lane >> 4;
  const size_t t0 = (size_t)tile * 128;
  for (int nc = 0; nc < 4; ++nc) {
    gemm_tile(WSP(u16, hb) + t0 * 1024, WSP(u16, WqT) + (size_t)nc * 256 * 1024, smem,
      [&](int tt, int ft, int wv, int l15, int quad) { return mkf4(WSP(float, rstd2)[t0 + tt * 16 + l15], 0.f, 0.f, 0.f); },
      [&](int tt, int ft, f32x4 v, f32x4 pvv, int wv, int l15, int quad) {
      int tl = tt * 16 + l15; size_t t = t0 + tl; int n = nc * 256 + wv * 64 + ft * 16 + quad * 4;
      float r = pvv[0];
      v[0] *= r; v[1] *= r; v[2] *= r; v[3] *= r;
      *(u32x2*)(WSP(u16, qp) + t * 1024 + n) = pack4(v);
    });
  }
}

DI void bitonic_sort16_desc(unsigned* a) {
#pragma unroll
  for (int k = 2; k <= 16; k <<= 1)
#pragma unroll
    for (int j = k >> 1; j > 0; j >>= 1)
#pragma unroll
      for (int i = 0; i < 16; ++i) {
        const int l = i ^ j;
        if (l > i) {
          const bool desc = ((i & k) == 0);
          const unsigned hi = max(a[i], a[l]), lo = min(a[i], a[l]);
          a[i] = desc ? hi : lo; a[l] = desc ? lo : hi;
        }
      }
}
DI void merge_top16(unsigned* a, const unsigned* b) {
#pragma unroll
  for (int i = 0; i < 16; ++i) a[i] = max(a[i], b[15 - i]);
#pragma unroll
  for (int j = 8; j > 0; j >>= 1)
#pragma unroll
    for (int i = 0; i < 16; ++i) {
      const int l = i ^ j;
      if (l > i) { const unsigned hi = max(a[i], a[l]), lo = min(a[i], a[l]); a[i] = hi; a[l] = lo; }
    }
}

constexpr unsigned char PEER_CAND[52] = {0, 1, 2, 3, 4, 5, 6, 7, 8, 9, 10, 11, 12, 13, 14, 15, 16, 17, 18, 19, 20, 21, 22, 23, 32, 33, 34, 35, 36, 48, 49, 50, 51, 64, 65, 66, 80, 81, 96, 97, 112, 113, 128, 144, 160, 176, 192, 208, 224, 240, 255, 255};

DI void p4_peer(const Params& p, int tile, char* smem) {
  const int tid = opaque_tid(), lane = tid & 63, wv = tid >> 6, l15 = lane & 15, quad = lane >> 4;
  const size_t t0 = (size_t)tile * 64;
  float* scb = (float*)smem;
  unsigned* tk = (unsigned*)(smem + 66048);
  float* rstd2 = (float*)(smem + 74752);
  __syncthreads();
  if (tid < 64) rstd2[tid] = WSP(float, rstd2)[t0 + tid];
  for (int h = 0; h < 8; ++h) {
    __syncthreads();
#pragma unroll
    for (int pp = 0; pp < 2; ++pp) {
      const u16* qrow = WSP(u16, qp) + (t0 + wv * 16 + l15) * 1024 + h * 128 + pp * 64 + quad * 8;
      bf16x8 tf0 = *(const bf16x8*)qrow, tf1 = *(const bf16x8*)(qrow + 32);
      const int list = (wv * 16 + l15) * 2 + pp;
#pragma unroll
      for (int nt = 0; nt < 8; ++nt) {
        const u16* krow = WSP(u16, keysb) + ((size_t)((h * 2 + pp) * 128) + nt * 16 + l15) * 64 + quad * 8;
        bf16x8 k0 = *(const bf16x8*)krow, k1 = *(const bf16x8*)(krow + 32);
        f32x4 a = fzero();
        a = mfma16(k0, tf0, a); a = mfma16(k1, tf1, a);
#pragma unroll
        for (int r = 0; r < 4; ++r) scb[list * 129 + nt * 16 + quad * 4 + r] = a[r];
      }
    }
    __syncthreads();
    {
      const int list = tid >> 1, half = tid & 1;
      unsigned best[16];
#pragma unroll
      for (int g = 0; g < 4; ++g) {
        unsigned cur[16];
#pragma unroll
        for (int i = 0; i < 16; ++i) {
          const int n = half * 64 + g * 16 + i;
          cur[i] = (enc_f(scb[list * 129 + n]) & ~127u) | (unsigned)n;
        }
        bitonic_sort16_desc(cur);
        if (g == 0) {
#pragma unroll
          for (int i = 0; i < 16; ++i) best[i] = cur[i];
        } else merge_top16(best, cur);
      }
      unsigned oth[16];
#pragma unroll
      for (int i = 0; i < 16; ++i) oth[i] = (unsigned)__shfl_xor((int)best[i], 1);
      merge_top16(best, oth);
      if (half == 0) {
#pragma unroll
        for (int i = 0; i < 16; ++i) tk[list * 17 + i] = best[i];
      }
    }
    __syncthreads();
    {
      const int tok = tid >> 2, role = tid & 3;
      const unsigned* ta = tk + (tok * 2) * 17;
      const unsigned* tb = tk + (tok * 2 + 1) * 17;
      unsigned top[16];
#pragma unroll
      for (int m = 0; m < 13; ++m) {
        const unsigned c0 = PEER_CAND[4 * m], c1 = PEER_CAND[4 * m + 1], c2 = PEER_CAND[4 * m + 2], c3 = PEER_CAND[4 * m + 3];
        const unsigned code = (role == 0) ? c0 : (role == 1) ? c1 : (role == 2) ? c2 : c3;
        const bool ok = code != 255u;
        const unsigned cc = ok ? code : 0u;
        const float sa = dec_f(ta[cc >> 4] & ~127u), sb = dec_f(tb[cc & 15u] & ~127u);
        top[m] = ok ? ((enc_f(sa + sb) & ~255u) | cc) : 0u;
      }
      top[13] = 0u; top[14] = 0u; top[15] = 0u;
      bitonic_sort16_desc(top);
      unsigned oth[16];
#pragma unroll
      for (int i = 0; i < 16; ++i) oth[i] = (unsigned)__shfl_xor((int)top[i], 1);
      merge_top16(top, oth);
#pragma unroll
      for (int i = 0; i < 16; ++i) oth[i] = (unsigned)__shfl_xor((int)top[i], 2);
      merge_top16(top, oth);
      const float mx = dec_f(top[0] & ~255u);
      unsigned mine[4]; float ev[4]; float sum = 0.f;
#pragma unroll
      for (int mm = 0; mm < 4; ++mm) {
        mine[mm] = (role == 0) ? top[mm] : (role == 1) ? top[4 + mm] : (role == 2) ? top[8 + mm] : top[12 + mm];
        ev[mm] = __expf(dec_f(mine[mm] & ~255u) - mx); sum += ev[mm];
      }
      sum += __shfl_xor(sum, 1); sum += __shfl_xor(sum, 2);
      const float isum = 1.f / sum;
      const size_t t = t0 + tok;
#pragma unroll
      for (int mm = 0; mm < 4; ++mm) {
        const unsigned code = mine[mm] & 255u;
        const unsigned ia = ta[code >> 4] & 127u, ib = tb[code & 15u] & 127u;
        WSP(int, pidx)[t * 128 + h * 16 + role * 4 + mm] = (int)(ia * 128u + ib);
        WSP(float, pgate)[t * 128 + h * 16 + role * 4 + mm] = ev[mm] * isum;
      }
    }
  }
  __syncthreads();
  u32x4 nh0, nh1; int nid0, nid1; float ng0, ng1;
  {
    const size_t t = t0 + wv * 16;
    const u32x4* hrow = (const u32x4*)(WSP(u16, hb) + t * 1024);
    nh0 = hrow[lane * 2]; nh1 = hrow[lane * 2 + 1];
    nid0 = WSP(int, pidx)[t * 128 + lane]; nid1 = WSP(int, pidx)[t * 128 + 64 + lane];
    ng0 = WSP(float, pgate)[t * 128 + lane]; ng1 = WSP(float, pgate)[t * 128 + 64 + lane];
  }
  for (int tt = 0; tt < 16; ++tt) {
    const int tl = wv * 16 + tt; const size_t t = t0 + tl;
    const float rs = rstd2[tl];
    const u32x4 ch0 = nh0, ch1 = nh1;
    const int id0 = nid0, id1 = nid1; const float g0 = ng0, g1 = ng1;
    {
      const size_t tn = t0 + wv * 16 + min(tt + 1, 15);
      const u32x4* hrow = (const u32x4*)(WSP(u16, hb) + tn * 1024);
      nh0 = hrow[lane * 2]; nh1 = hrow[lane * 2 + 1];
      nid0 = WSP(int, pidx)[tn * 128 + lane]; nid1 = WSP(int, pidx)[tn * 128 + 64 + lane];
      ng0 = WSP(float, pgate)[tn * 128 + lane]; ng1 = WSP(float, pgate)[tn * 128 + 64 + lane];
    }
    float xf[16]; unpack8(ch0, xf); unpack8(ch1, xf + 8);
    float xm = 0.f;
#pragma unroll
    for (int i = 0; i < 16; ++i) xm = fmaxf(xm, fabsf(xf[i]));
#pragma unroll
    for (int o = 32; o > 0; o >>= 1) xm = fmaxf(xm, __shfl_xor(xm, o));
    xm = fmaxf(xm, 1e-30f);
    const float xinv = 127.f / xm;
    const float sxrs = xm * (1.f / 127.f) * rs;
    int xq[4];
#pragma unroll
    for (int i = 0; i < 4; ++i) {
      unsigned b0 = (unsigned)(int)rintf(xf[4 * i] * xinv) & 0xffu, b1 = (unsigned)(int)rintf(xf[4 * i + 1] * xinv) & 0xffu;
      unsigned b2 = (unsigned)(int)rintf(xf[4 * i + 2] * xinv) & 0xffu, b3 = (unsigned)(int)rintf(xf[4 * i + 3] * xinv) & 0xffu;
      xq[i] = (int)(b0 | (b1 << 8) | (b2 << 16) | (b3 << 24));
    }
    float acc[16];
#pragma unroll
    for (int i = 0; i < 16; ++i) acc[i] = 0.f;
    float corr = 0.f;
    u32x4 ua[4], va[4]; float gt[4], su[4], sv[4];
    u32x4 nua[4], nva[4]; float ngt[4], nsu[4], nsv[4];
#pragma unroll
    for (int j = 0; j < 4; ++j) {
      const int e = __builtin_amdgcn_readlane(id0, j);
      gt[j] = __uint_as_float(__builtin_amdgcn_readlane(__float_as_uint(g0), j));
      ua[j] = ((const u32x4*)(p.ws + OFF_ub))[(size_t)e * 128 + lane];
      va[j] = ((const u32x4*)(p.ws + OFF_ub))[(size_t)e * 128 + 64 + lane];
      su[j] = WSP(float, us)[e]; sv[j] = WSP(float, vs)[e];
    }
    for (int k0 = 0; k0 < 128; k0 += 4) {
      {
        const int kn = min(k0 + 4, 124);
        const int ids = (kn < 64) ? id0 : id1; const float gs = (kn < 64) ? g0 : g1;
#pragma unroll
        for (int j = 0; j < 4; ++j) {
          const int e = __builtin_amdgcn_readlane(ids, (kn + j) & 63);
          ngt[j] = __uint_as_float(__builtin_amdgcn_readlane(__float_as_uint(gs), (kn + j) & 63));
          nua[j] = ((const u32x4*)(p.ws + OFF_ub))[(size_t)e * 128 + lane];
          nva[j] = ((const u32x4*)(p.ws + OFF_ub))[(size_t)e * 128 + 64 + lane];
          nsu[j] = WSP(float, us)[e]; nsv[j] = WSP(float, vs)[e];
        }
      }
      int d[4];
#pragma unroll
      for (int j = 0; j < 4; ++j) {
        int a = 0;
#pragma unroll
        for (int i = 0; i < 4; ++i) a = __builtin_amdgcn_sdot4((int)ua[j][i], xq[i], a, false);
        d[j] = a;
      }
      const bool b0 = lane & 1, b1 = lane & 2;
      int k0v = b0 ? d[1] : d[0], s0v = b0 ? d[0] : d[1];
      int k1v = b0 ? d[3] : d[2], s1v = b0 ? d[2] : d[3];
      k0v += __shfl_xor(s0v, 1); k1v += __shfl_xor(s1v, 1);
      int kv = b1 ? k1v : k0v, sv2 = b1 ? k0v : k1v;
      kv += __shfl_xor(sv2, 2);
      kv += __shfl_xor(kv, 4); kv += __shfl_xor(kv, 8); kv += __shfl_xor(kv, 16); kv += __shfl_xor(kv, 32);
      const int jm = lane & 3;
      const float su_l = (jm == 0) ? su[0] : (jm == 1) ? su[1] : (jm == 2) ? su[2] : su[3];
      const float sv_l = (jm == 0) ? sv[0] : (jm == 1) ? sv[1] : (jm == 2) ? sv[2] : sv[3];
      const float gt_l = (jm == 0) ? gt[0] : (jm == 1) ? gt[1] : (jm == 2) ? gt[2] : gt[3];
      const float pre = (float)kv * su_l * sxrs;
      const float a_l = 0.5f * pre * (1.f + erff(pre * 0.70710678118654752f)) * gt_l * sv_l;
#pragma unroll
      for (int j = 0; j < 4; ++j) {
        const float a = __uint_as_float(__builtin_amdgcn_readlane(__float_as_uint(a_l), j));
        corr += a;
#pragma unroll
        for (int i = 0; i < 4; ++i) {
          const unsigned wd = va[j][i];
          acc[4 * i] += a * (float)(wd & 0xffu); acc[4 * i + 1] += a * (float)((wd >> 8) & 0xffu);
          acc[4 * i + 2] += a * (float)((wd >> 16) & 0xffu); acc[4 * i + 3] += a * (float)(wd >> 24);
        }
      }
#pragma unroll
      for (int j = 0; j < 4; ++j) { ua[j] = nua[j]; va[j] = nva[j]; gt[j] = ngt[j]; su[j] = nsu[j]; sv[j] = nsv[j]; }
    }
    const float c128 = 128.f * corr;
    float hf[16]; unpack8(ch0, hf); unpack8(ch1, hf + 8);
    f32x4* orow = (f32x4*)(p.out + t * 1024) + lane * 4;
#pragma unroll
    for (int i = 0; i < 4; ++i)
      orow[i] = mkf4(hf[4 * i] + acc[4 * i] - c128, hf[4 * i + 1] + acc[4 * i + 1] - c128, hf[4 * i + 2] + acc[4 * i + 2] - c128,
                     hf[4 * i + 3] + acc[4 * i + 3] - c128);
  }
}

DI void grid_barrier(unsigned* ctr, unsigned target) {
  __syncthreads();
  if (threadIdx.x == 0) {
    __builtin_amdgcn_fence(__ATOMIC_RELEASE, "agent");
    asm volatile("s_waitcnt vmcnt(0)" ::: "memory");
    __hip_atomic_fetch_add(ctr, 1u, __ATOMIC_RELAXED, __HIP_MEMORY_SCOPE_AGENT);
    while (__hip_atomic_load(ctr, __ATOMIC_RELAXED, __HIP_MEMORY_SCOPE_AGENT) < target) __builtin_amdgcn_s_sleep(2);
    __builtin_amdgcn_fence(__ATOMIC_ACQUIRE, "agent");
    asm volatile("s_waitcnt vmcnt(0)" ::: "memory");
  }
  __syncthreads();
}

#ifndef NOMAIN
__global__ void __launch_bounds__(256, 2) hybrid_megakernel(Params p) {
  __shared__ __attribute__((aligned(16))) char smem[SMEM_BYTES];
  cg::grid_group grid = cg::this_grid();
  unsigned* bar = (unsigned*)(p.ws + OFF_bar);
  if (blockIdx.x == 0 && threadIdx.x == 0) __hip_atomic_store(bar, 0u, __ATOMIC_RELAXED, __HIP_MEMORY_SCOPE_AGENT);
  phase0(p, smem);
  grid.sync();
  phase1(p, smem);
  grid_barrier(bar, gridDim.x);
  for (int item = blockIdx.x; item < 512; item += gridDim.x) attn_item(p, item, smem);
  for (int item = blockIdx.x; item < 4096; item += gridDim.x) dn_chunk_item(p, item, smem);
  grid_barrier(bar, 2 * gridDim.x);
  for (int item = blockIdx.x; item < 512; item += gridDim.x) dn_scan_item(p, item, smem);
  grid_barrier(bar, 3 * gridDim.x);
  for (int tile = blockIdx.x; tile < 512; tile += gridDim.x) p4_gemm2(p, tile, smem);
  __syncthreads();
  for (int tile = blockIdx.x; tile < 512; tile += gridDim.x) p4_gemm3(p, tile, smem);
  __syncthreads();
  for (int tile = blockIdx.x; tile < 512; tile += gridDim.x) { p4_peer(p, 2 * tile, smem); p4_peer(p, 2 * tile + 1, smem); }
}

extern "C" void kernel_launch(void* const* d_in, const int* in_sizes, int n_in, void* d_out, int out_size, void* d_ws, size_t ws_size,
                              hipStream_t stream) {
  static int grid_blocks = 0;
  if (!grid_blocks) {
    int dev = 0, cus = 0, per_cu = 0;
    hipGetDevice(&dev);
    hipDeviceGetAttribute(&cus, hipDeviceAttributeMultiprocessorCount, dev);
    hipOccupancyMaxActiveBlocksPerMultiprocessor(&per_cu, hybrid_megakernel, 256, 0);
    if (per_cu > 2) per_cu = 2;
    grid_blocks = cus * per_cu;
  }
  Params p{};
  p.x = (const float*)d_in[0]; p.g1 = (const float*)d_in[1]; p.w_in = (const float*)d_in[2]; p.gq = (const float*)d_in[3];
  p.gk = (const float*)d_in[4]; p.sinks = (const float*)d_in[5]; p.g_att = (const float*)d_in[6]; p.convw = (const float*)d_in[7];
  p.a_log = (const float*)d_in[8]; p.dt_bias = (const float*)d_in[9]; p.g_o = (const float*)d_in[10]; p.w_out = (const float*)d_in[11];
  p.g_ffn = (const float*)d_in[12]; p.w_q = (const float*)d_in[13]; p.keys = (const float*)d_in[14]; p.pu = (const float*)d_in[15];
  p.pv = (const float*)d_in[16];
  p.out = (float*)d_out;
  p.ws = (char*)d_ws;
  if (WS_TOTAL > ws_size) { fprintf(stderr, "workspace too small: need %zu have %zu\n", (size_t)WS_TOTAL, ws_size); return; }
  void* args[] = {&p};
  hipError_t e = hipLaunchCooperativeKernel((void*)hybrid_megakernel, dim3(grid_blocks), dim3(256), args, 0, stream);
  if (e != hipSuccess) fprintf(stderr, "cooperative launch failed: %s (grid %d)\n", hipGetErrorString(e), grid_blocks);
}
#endif
```

```cpp
#include <hip/hip_runtime.h>
#include <hip/hip_cooperative_groups.h>
#include <cstdio>
namespace cg = cooperative_groups;

#define DI __device__ __forceinline__
typedef unsigned short u16;
typedef __attribute__((ext_vector_type(8))) short bf16x8;
typedef __attribute__((ext_vector_type(4))) float f32x4;
typedef __attribute__((ext_vector_type(4))) unsigned u32x4;
typedef __attribute__((ext_vector_type(2))) unsigned u32x2;

constexpr int T = 65536;
constexpr int NP = 2816;
constexpr int SMEM_BYTES = 75776;
constexpr float EPS = 1e-6f;

struct Params {
  const float *x, *g1, *w_in, *gq, *gk, *sinks, *g_att, *convw, *a_log, *dt_bias, *g_o, *w_out, *g_ffn, *w_q, *keys, *pu, *pv;
  float* out;
  char* ws;
};
constexpr size_t MiB = 1024 * 1024;
constexpr size_t OFF_mixA = 0, OFF_proj = 128 * MiB, OFF_u_ = 480 * MiB, OFF_w_ = 544 * MiB, OFF_qd = 608 * MiB, OFF_kdT = 672 * MiB,
                 OFF_qk = 736 * MiB, OFF_ub = 768 * MiB, OFF_vb = 800 * MiB, OFF_WinT = 832 * MiB, OFF_WoutT = 838 * MiB, OFF_WqT = 840 * MiB,
                 OFF_keysb = 842 * MiB, OFF_pgate = 843 * MiB, OFF_rstd1 = 875 * MiB, OFF_rstd_att = 876 * MiB, OFF_rstd2 = 876 * MiB + 524288, OFF_gate_g = 877 * MiB,
                 OFF_gate_b = 878 * MiB, OFF_cd = 879 * MiB, OFF_bar = 879 * MiB + 32768, OFF_us = 879 * MiB + 65536, OFF_vs = 879 * MiB + 131072, WS_TOTAL = 880 * MiB;
constexpr size_t OFF_hb = OFF_u_, OFF_qp = OFF_qd, OFF_pidx = OFF_qk;
#define WSP(type, name) ((type*)(p.ws + OFF_##name))

DI int opaque_tid() { int t = threadIdx.x; asm volatile("" : "+v"(t)); return t; }
DI void lds_barrier() { asm volatile("s_waitcnt lgkmcnt(0)\n\ts_barrier" ::: "memory"); }
DI u32x4 mk4(unsigned a, unsigned b, unsigned c, unsigned d) { u32x4 r = {a, b, c, d}; return r; }
DI u32x2 mk2(unsigned a, unsigned b) { u32x2 r = {a, b}; return r; }
DI f32x4 mkf4(float a, float b, float c, float d) { f32x4 r = {a, b, c, d}; return r; }
typedef __bf16 bf16x2_t __attribute__((ext_vector_type(2)));
DI u16 f2bf(float f) { __bf16 v = (__bf16)f; return __builtin_bit_cast(u16, v); }
DI float bf2f(u16 h) { return __uint_as_float(((unsigned)h) << 16); }
DI unsigned pk(float a, float b) { bf16x2_t v = {(__bf16)a, (__bf16)b}; return __builtin_bit_cast(unsigned, v); }
DI float bflo(unsigned u) { return __uint_as_float(u << 16); }
DI float bfhi(unsigned u) { return __uint_as_float(u & 0xffff0000u); }
DI f32x4 mfma16(bf16x8 a, bf16x8 b, f32x4 c) { return __builtin_amdgcn_mfma_f32_16x16x32_bf16(a, b, c, 0, 0, 0); }
DI float wsum(float v) {
#pragma unroll
  for (int o = 32; o > 0; o >>= 1) v += __shfl_xor(v, o);
  return v;
}
DI void unpack8(u32x4 v, float* f) {
  f[0] = bflo(v.x); f[1] = bfhi(v.x); f[2] = bflo(v.y); f[3] = bfhi(v.y);
  f[4] = bflo(v.z); f[5] = bfhi(v.z); f[6] = bflo(v.w); f[7] = bfhi(v.w);
}
DI u32x4 pack8(const float* f) { return mk4(pk(f[0], f[1]), pk(f[2], f[3]), pk(f[4], f[5]), pk(f[6], f[7])); }
DI bf16x8 as_frag(u32x4 v) { return __builtin_bit_cast(bf16x8, v); }
DI u32x2 pack4(f32x4 v) { return mk2(pk(v[0], v[1]), pk(v[2], v[3])); }
DI f32x4 fzero() { f32x4 z = {0.f, 0.f, 0.f, 0.f}; return z; }

DI void transpose_tile(const float* __restrict__ src, int ld, int col0, const float* __restrict__ scale, u16* __restrict__ dst,
                       int kt, int nt, float* tl) {
  const int tid = threadIdx.x;
  __syncthreads();
  float tv[16];
#pragma unroll
  for (int i = 0; i < 16; ++i) {
    int r = i * 4 + (tid >> 6), c = tid & 63;
    int k = kt * 64 + r;
    float s = scale ? scale[k] : 1.f;
    tv[i] = src[(size_t)k * ld + col0 + c] * s;
  }
#pragma unroll
  for (int i = 0; i < 16; ++i) { int r = i * 4 + (tid >> 6), c = tid & 63; tl[r * 65 + c] = tv[i]; }
  __syncthreads();
#pragma unroll 4
  for (int i = 0; i < 16; ++i) {
    int n = i * 4 + (tid >> 6), k = tid & 63;
    const int ng = nt * 64 + n, kg = kt * 64 + k;
    dst[((size_t)((ng >> 4) * 32 + (kg >> 5)) * 64 + ((kg >> 3) & 3) * 16 + (ng & 15)) * 8 + (kg & 7)] = f2bf(tl[k * 65 + n]);
  }
}

DI void phase0(const Params& p, char* smem) {
  const int tid = opaque_tid(), lane = tid & 63, wv = tid >> 6;
  {
    float* tl = (float*)smem;
    for (int tile = blockIdx.x; tile < 1216; tile += gridDim.x) {
      if (tile < 704) {
        int kt = tile / 44, nt = tile % 44;
        int n0 = nt * 64;
        int col0 = (n0 < 2304) ? n0 : n0 + 8;
        transpose_tile(p.w_in, 2824, col0, p.g1, WSP(u16, WinT), kt, nt, tl);
      } else if (tile < 960) {
        int t2 = tile - 704; int kt = t2 >> 4, nt = t2 & 15;
        transpose_tile(p.w_out, 1024, nt * 64, (kt < 8) ? p.g_att : nullptr, WSP(u16, WoutT), kt, nt, tl);
      } else {
        int t2 = tile - 960; int kt = t2 >> 4, nt = t2 & 15;
        transpose_tile(p.w_q, 1024, nt * 64, p.g_ffn, WSP(u16, WqT), kt, nt, tl);
      }
    }
    __syncthreads();
  }
  {
    const int gw = blockIdx.x * 4 + wv, nw = gridDim.x * 4;
    f32x4 v[4], vn[4];
    if (gw < 32768) {
      const f32x4* src = (const f32x4*)(((gw < 16384) ? p.pu : p.pv) + (size_t)(gw & 16383) * 1024);
#pragma unroll
      for (int i = 0; i < 4; ++i) v[i] = src[lane * 4 + i];
    }
    for (int row = gw; row < 32768; row += nw) {
      const bool isu = row < 16384;
      const int e = row & 16383;
      {
        const int rn = min(row + nw, 32767);
        const f32x4* srcn = (const f32x4*)(((rn < 16384) ? p.pu : p.pv) + (size_t)(rn & 16383) * 1024);
#pragma unroll
        for (int i = 0; i < 4; ++i) vn[i] = srcn[lane * 4 + i];
      }
#pragma unroll
      for (int i = 0; i < 4; ++i) {
        if (isu) { f32x4 g = ((const f32x4*)p.g_ffn)[lane * 4 + i]; v[i] *= g; }
      }
      float mx = 0.f;
#pragma unroll
      for (int i = 0; i < 4; ++i) mx = fmaxf(mx, fmaxf(fmaxf(fabsf(v[i].x), fabsf(v[i].y)), fmaxf(fabsf(v[i].z), fabsf(v[i].w))));
#pragma unroll
      for (int o = 32; o > 0; o >>= 1) mx = fmaxf(mx, __shfl_xor(mx, o));
      mx = fmaxf(mx, 1e-30f);
      const float inv = 127.f / mx;
      unsigned w[4];
#pragma unroll
      for (int i = 0; i < 4; ++i) {
        const float ofs = isu ? 0.f : 128.f;
        unsigned b0 = (unsigned)(int)(rintf(v[i].x * inv) + ofs) & 0xffu, b1 = (unsigned)(int)(rintf(v[i].y * inv) + ofs) & 0xffu;
        unsigned b2 = (unsigned)(int)(rintf(v[i].z * inv) + ofs) & 0xffu, b3 = (unsigned)(int)(rintf(v[i].w * inv) + ofs) & 0xffu;
        w[i] = b0 | (b1 << 8) | (b2 << 16) | (b3 << 24);
      }
      u32x4* dst = (u32x4*)(p.ws + OFF_ub) + (size_t)e * 128 + (isu ? 0 : 64) + lane;
      *dst = mk4(w[0], w[1], w[2], w[3]);
      if (lane == 0) ((float*)(p.ws + (isu ? OFF_us : OFF_vs)))[e] = mx * (1.f / 127.f);
#pragma unroll
      for (int i = 0; i < 4; ++i) v[i] = vn[i];
    }
    const size_t gtid = (size_t)blockIdx.x * 256 + tid, gsz = (size_t)gridDim.x * 256;
    for (size_t i = gtid; i < 131072 / 4; i += gsz) {
      f32x4 a = ((const f32x4*)p.keys)[i];
      ((u32x2*)WSP(u16, keysb))[i] = mk2(pk(a.x, a.y), pk(a.z, a.w));
    }
  }
  {
    float* wg = (float*)smem;
    {
      float tmp[32];
#pragma unroll
      for (int r = 0; r < 32; ++r) { int i = tid + 256 * r; int k = i >> 3, j = i & 7; tmp[r] = p.g1[k] * p.w_in[(size_t)k * 2824 + 2304 + j]; }
#pragma unroll
      for (int r = 0; r < 32; ++r) { int i = tid + 256 * r; int k = i >> 3, j = i & 7; wg[j * 1024 + k] = tmp[r]; }
    }
    __syncthreads();
    const int gw = blockIdx.x * 4 + wv, nw = gridDim.x * 4;
    f32x4 v[4], vn[4];
    if (gw < T) {
#pragma unroll
      for (int i = 0; i < 4; ++i) v[i] = ((const f32x4*)(p.x + (size_t)gw * 1024))[lane + 64 * i];
    }
    for (int row = gw; row < T; row += nw) {
      {
        const int rn = min(row + nw, T - 1);
#pragma unroll
        for (int i = 0; i < 4; ++i) vn[i] = ((const f32x4*)(p.x + (size_t)rn * 1024))[lane + 64 * i];
      }
      float ss = 0.f; float ga[8];
#pragma unroll
      for (int j = 0; j < 8; ++j) ga[j] = 0.f;
#pragma unroll
      for (int i = 0; i < 4; ++i) {
        ss += v[i].x * v[i].x + v[i].y * v[i].y + v[i].z * v[i].z + v[i].w * v[i].w;
#pragma unroll
        for (int j = 0; j < 8; ++j) {
          f32x4 w = ((const f32x4*)(wg + j * 1024))[lane + 64 * i];
          ga[j] += v[i].x * w.x + v[i].y * w.y + v[i].z * w.z + v[i].w * w.w;
        }
      }
      ss = wsum(ss);
      float mine;
      {
        const bool b0 = lane & 1, b1 = lane & 2, b2 = lane & 4;
        float k1[4], q1[2];
#pragma unroll
        for (int m = 0; m < 4; ++m) { float kp = b0 ? ga[2 * m + 1] : ga[2 * m], sd = b0 ? ga[2 * m] : ga[2 * m + 1]; k1[m] = kp + __shfl_xor(sd, 1); }
#pragma unroll
        for (int m = 0; m < 2; ++m) { float kp = b1 ? k1[2 * m + 1] : k1[2 * m], sd = b1 ? k1[2 * m] : k1[2 * m + 1]; q1[m] = kp + __shfl_xor(sd, 2); }
        mine = (b2 ? q1[1] : q1[0]) + __shfl_xor(b2 ? q1[0] : q1[1], 4);
        mine += __shfl_xor(mine, 8); mine += __shfl_xor(mine, 16); mine += __shfl_xor(mine, 32);
      }
      const float rstd = rsqrtf(ss * (1.f / 1024.f) + EPS);
      u32x2* xo = (u32x2*)(WSP(u16, mixA) + (size_t)row * 1024);
#pragma unroll
      for (int i = 0; i < 4; ++i) xo[lane + 64 * i] = mk2(pk(v[i].x, v[i].y), pk(v[i].z, v[i].w));
      if (lane == 0) WSP(float, rstd1)[row] = rstd;
      if (lane < 8) {
        float a = mine * rstd; int hh = lane & 3;
        if (lane < 4) {
          float xx = a + p.dt_bias[hh];
          float sp = (xx > 20.f) ? xx : log1pf(expf(xx));
          WSP(float, gate_g)[(size_t)row * 4 + hh] = -expf(p.a_log[hh]) * sp;
        } else {
          WSP(float, gate_b)[(size_t)row * 4 + hh] = 1.f / (1.f + expf(-a));
        }
      }
#pragma unroll
      for (int i = 0; i < 4; ++i) v[i] = vn[i];
    }
  }
}

template <class Pre, class Epi>
DI void gemm_tile(const u16* __restrict__ A, const u16* __restrict__ Bt, char* smem, Pre&& pre, Epi&& epi) {
  u16* As = (u16*)smem;
  const int tid = opaque_tid(), lane = tid & 63, wv = tid >> 6, l15 = lane & 15, quad = lane >> 4;
  f32x4 acc[4][8];
#pragma unroll
  for (int i = 0; i < 4; ++i)
#pragma unroll
    for (int j = 0; j < 8; ++j) acc[i][j] = fzero();
  u32x4 pa[4];
  bf16x8 w0[2][4], w1[2][4];
  const int lr = tid >> 3, lc = tid & 7;
  const u16* Ag = A + (size_t)lr * 1024 + lc * 8;
  const u16* Wg = Bt + ((size_t)(wv * 4) * 32 * 64 + lane) * 8;
#define GEMM_WLOAD(W, KT)                                                                          \
  {                                                                                               \
    _Pragma("unroll") for (int kk = 0; kk < 2; ++kk)                                              \
      _Pragma("unroll") for (int ft = 0; ft < 4; ++ft) W[kk][ft] = *(const bf16x8*)(Wg + (size_t)((ft * 32 + (KT) * 2 + kk) * 64) * 8); \
  }
#define GEMM_ALOAD(KT)                                                                             \
  { _Pragma("unroll") for (int i = 0; i < 4; ++i) pa[i] = *(const u32x4*)(Ag + (size_t)i * 32 * 1024 + (KT) * 64); }
#define GEMM_STEP(WC, WN, KT)                                                                      \
  {                                                                                               \
    __syncthreads();                                                                              \
    _Pragma("unroll") for (int i = 0; i < 4; ++i) *(u32x4*)(As + (lr + 32 * i) * 64 + ((lc ^ (lr & 7)) * 8)) = pa[i]; \
    __syncthreads();                                                                              \
    GEMM_ALOAD(min((KT) + 1, 15))                                                                 \
    GEMM_WLOAD(WN, min((KT) + 1, 15))                                                             \
    _Pragma("unroll") for (int kk = 0; kk < 2; ++kk) {                                            \
      _Pragma("unroll") for (int th = 0; th < 2; ++th) {                                          \
        bf16x8 af[4];                                                                             \
        _Pragma("unroll") for (int tt = 0; tt < 4; ++tt) af[tt] = *(const bf16x8*)(As + ((th * 4 + tt) * 16 + l15) * 64 + (((kk * 4 + quad) ^ (l15 & 7)) * 8)); \
        _Pragma("unroll") for (int ft = 0; ft < 4; ++ft)                                          \
          _Pragma("unroll") for (int tt = 0; tt < 4; ++tt) acc[ft][th * 4 + tt] = mfma16(WC[kk][ft], af[tt], acc[ft][th * 4 + tt]); \
        if (th == 1) __builtin_amdgcn_sched_barrier(0);     \
      }                                                                                           \
    }                                                                                             \
  }
  GEMM_ALOAD(0)
  GEMM_WLOAD(w0, 0)
  for (int kt = 0; kt < 16; kt += 2) {
    GEMM_STEP(w0, w1, kt)
    GEMM_STEP(w1, w0, kt + 1)
  }
#undef GEMM_WLOAD
#undef GEMM_ALOAD
#undef GEMM_STEP
  const int et = opaque_tid();
  const int el = et & 63, ewv = et >> 6, el15 = el & 15, equad = el >> 4;
#pragma unroll
  for (int th = 0; th < 2; ++th) {
    f32x4 pv[4][4];
#pragma unroll
    for (int ft = 0; ft < 4; ++ft)
#pragma unroll
      for (int tt = 0; tt < 4; ++tt) pv[ft][tt] = pre(th * 4 + tt, ft, ewv, el15, equad);
#pragma unroll
    for (int ft = 0; ft < 4; ++ft)
#pragma unroll
      for (int tt = 0; tt < 4; ++tt) epi(th * 4 + tt, ft, acc[ft][th * 4 + tt], pv[ft][tt], ewv, el15, equad);
    __builtin_amdgcn_sched_barrier(0);
  }
}

DI void phase1(const Params& p, char* smem) {
  const int tid_ = opaque_tid(); const int lane = tid_ & 63, wv = tid_ >> 6, l15 = lane & 15, quad = lane >> 4;
  const bool xcd_order = (gridDim.x & 7) == 0;
  const int xcd = blockIdx.x & 7, jb = blockIdx.x >> 3, nxb = gridDim.x >> 3;
  for (int it = xcd_order ? jb : (int)blockIdx.x; it < (xcd_order ? 704 : 5632); it += (xcd_order ? nxb : (int)gridDim.x)) {
    int mt, nt;
    if (xcd_order) {
      if (it < 640) { int np = it >> 7, r = it & 127; mt = xcd * 64 + (r >> 1); nt = 2 * np + (r & 1); }
      else { mt = xcd * 64 + (it - 640); nt = 10; }
    } else { mt = it / 11; nt = it % 11; }
    gemm_tile(WSP(u16, mixA) + (size_t)mt * 128 * 1024, WSP(u16, WinT) + (size_t)nt * 256 * 1024, smem,
      [&](int tt, int ft, int wv, int l15, int quad) { return mkf4(WSP(float, rstd1)[(size_t)mt * 128 + tt * 16 + l15], 0.f, 0.f, 0.f); },
      [&](int tt, int ft, f32x4 v, f32x4 pvv, int wv, int l15, int quad) {
      size_t t = (size_t)mt * 128 + tt * 16 + l15; int n = nt * 256 + wv * 64 + ft * 16 + quad * 4;
      float r = pvv[0];
      v[0] *= r; v[1] *= r; v[2] *= r; v[3] *= r;
      *(u32x2*)(WSP(u16, proj) + t * NP + n) = pack4(v);
    });
  }
}

DI void attn_item(const Params& p, int item, char* smem) {
  const int b = item >> 5, nb = item & 31;
  u16* Ks = (u16*)smem;
  u16* Vt = Ks + 256 * 72;
  const int tid = opaque_tid(), lane = tid & 63, wv = tid >> 6, l15 = lane & 15, quad = lane >> 4;
  const size_t tq0 = (size_t)b * 4096 + (size_t)nb * 128;
  float ssq0 = 0.f, ssq1 = 0.f;
  u32x4 qr0, qr1, qn0, qn1;
  {
    const u16* row = WSP(u16, proj) + (tq0 + wv * 32 + l15) * NP;
    qr0 = *(const u32x4*)(row + quad * 8); qr1 = *(const u32x4*)(row + 32 + quad * 8);
  }
#pragma unroll 1
  for (int it = 0; it < 16; ++it) {
    const int h = it >> 1, qt = it & 1, kvh = h >> 2;
    if ((it & 7) == 0) {
      __syncthreads();
      u32x4 kr[8], vr[8];
#pragma unroll
      for (int i = 0; i < 8; ++i) {
        int ch = tid + 256 * i; int kj = ch >> 3, c = ch & 7;
        int pos = max(nb * 128 - 128 + kj, 0);
        const u16* row = WSP(u16, proj) + ((size_t)b * 4096 + pos) * NP;
        kr[i] = *(const u32x4*)(row + 512 + kvh * 64 + c * 8);
        vr[i] = *(const u32x4*)(row + 640 + kvh * 64 + c * 8);
      }
#pragma unroll
      for (int i = 0; i < 8; ++i) {
        int ch = tid + 256 * i; int kj = ch >> 3, c = ch & 7;
        const bool valid = (nb * 128 - 128 + kj) >= 0;
        float kf[8]; unpack8(kr[i], kf);
        float s = 0.f;
#pragma unroll
        for (int e = 0; e < 8; ++e) s += kf[e] * kf[e];
        s += __shfl_xor(s, 1); s += __shfl_xor(s, 2); s += __shfl_xor(s, 4);
        float r = valid ? rsqrtf(s * (1.f / 64.f) + EPS) : 0.f;
#pragma unroll
        for (int e = 0; e < 8; ++e) kf[e] = kf[e] * r * p.gk[c * 8 + e];
        *(u32x4*)(Ks + kj * 72 + c * 8) = pack8(kf);
#pragma unroll
        for (int e = 0; e < 4; ++e) {
          unsigned wd = valid ? vr[i][e] : 0u;
          Vt[(c * 8 + 2 * e) * 264 + kj] = (u16)(wd & 0xffffu); Vt[(c * 8 + 2 * e + 1) * 264 + kj] = (u16)(wd >> 16);
        }
      }
      __syncthreads();
    }
    {
      const int itn = min(it + 1, 15);
      const u16* row = WSP(u16, proj) + (tq0 + wv * 32 + (itn & 1) * 16 + l15) * NP + (itn >> 1) * 64;
      qn0 = *(const u32x4*)(row + quad * 8); qn1 = *(const u32x4*)(row + 32 + quad * 8);
    }
    {
      const float sink = p.sinks[h];
      const int qi = wv * 32 + qt * 16 + l15;
      bf16x8 qf0, qf1;
      {
        float f0[8], f1[8]; unpack8(qr0, f0); unpack8(qr1, f1);
        float s = 0.f;
#pragma unroll
        for (int e = 0; e < 8; ++e) s += f0[e] * f0[e] + f1[e] * f1[e];
        s += __shfl_xor(s, 16); s += __shfl_xor(s, 32);
        float r = rsqrtf(s * (1.f / 64.f) + EPS) * 0.125f;
#pragma unroll
        for (int e = 0; e < 8; ++e) { f0[e] *= r * p.gq[quad * 8 + e]; f1[e] *= r * p.gq[32 + quad * 8 + e]; }
        qf0 = as_frag(pack8(f0)); qf1 = as_frag(pack8(f1));
      }
      f32x4 S[10];
#pragma unroll
      for (int i = 0; i < 10; ++i) {
        int kj0 = (2 * wv + i) * 16;
        bf16x8 k0 = *(const bf16x8*)(Ks + (kj0 + l15) * 72 + quad * 8);
        bf16x8 k1 = *(const bf16x8*)(Ks + (kj0 + l15) * 72 + 32 + quad * 8);
        f32x4 a = fzero();
        a = mfma16(k0, qf0, a);
        a = mfma16(k1, qf1, a);
        S[i] = a;
        if (i & 1) __builtin_amdgcn_sched_barrier(0);
      }
      float mx = -INFINITY;
#pragma unroll
      for (int i = 0; i < 10; ++i) {
        const bool interior = (i >= qt + 1) && (i <= qt + 7) && (nb > 0);
        if (interior) {
#pragma unroll
          for (int r = 0; r < 4; ++r) mx = fmaxf(mx, S[i][r]);
        } else {
#pragma unroll
          for (int r = 0; r < 4; ++r) {
            int kj = (2 * wv + i) * 16 + quad * 4 + r;
            int rel = qi + 128 - kj;
            bool ok = (rel >= 0) && (rel < 128) && (nb > 0 || kj >= 128);
            float s = ok ? S[i][r] : -INFINITY;
            S[i][r] = s; mx = fmaxf(mx, s);
          }
        }
      }
      mx = fmaxf(mx, __shfl_xor(mx, 16)); mx = fmaxf(mx, __shfl_xor(mx, 32));
      const float m = fmaxf(mx, sink);
      float sum = 0.f;
#pragma unroll
      for (int i = 0; i < 10; ++i)
#pragma unroll
        for (int r = 0; r < 4; ++r) { float pv = __expf(S[i][r] - m); S[i][r] = pv; sum += pv; }
      sum += __shfl_xor(sum, 16); sum += __shfl_xor(sum, 32);
      const float inv = 1.f / (sum + __expf(sink - m));
      f32x4 O[4];
#pragma unroll
      for (int dt = 0; dt < 4; ++dt) O[dt] = fzero();
#pragma unroll
      for (int ip = 0; ip < 5; ++ip) {
        const int kja = (2 * wv + 2 * ip) * 16 + quad * 4, kjb = kja + 16;
        f32x4 a = S[2 * ip], c = S[2 * ip + 1];
        bf16x8 pf = as_frag(mk4(pk(a[0], a[1]), pk(a[2], a[3]), pk(c[0], c[1]), pk(c[2], c[3])));
#pragma unroll
        for (int dt = 0; dt < 4; ++dt) {
          int d = dt * 16 + l15;
          u32x2 va = *(const u32x2*)(Vt + d * 264 + kja), vb2 = *(const u32x2*)(Vt + d * 264 + kjb);
          bf16x8 vf = as_frag(mk4(va.x, va.y, vb2.x, vb2.y));
          O[dt] = mfma16(vf, pf, O[dt]);
        }
        __builtin_amdgcn_sched_barrier(0);
      }
      float sq = 0.f;
      const size_t t = tq0 + qi;
#pragma unroll
      for (int dt = 0; dt < 4; ++dt) {
        f32x4 o = O[dt];
        o[0] *= inv; o[1] *= inv; o[2] *= inv; o[3] *= inv;
        sq += o[0] * o[0] + o[1] * o[1] + o[2] * o[2] + o[3] * o[3];
        *(u32x2*)(WSP(u16, mixA) + t * 1024 + h * 64 + dt * 16 + quad * 4) = pack4(o);
      }
      ssq0 += (qt == 0) ? sq : 0.f; ssq1 += (qt == 0) ? 0.f : sq;
    }
    qr0 = qn0; qr1 = qn1;
  }
  {
    float s = ssq0;
    s += __shfl_xor(s, 16); s += __shfl_xor(s, 32);
    const float r0 = rsqrtf(s * (1.f / 512.f) + EPS);
    s = ssq1;
    s += __shfl_xor(s, 16); s += __shfl_xor(s, 32);
    const float r1 = rsqrtf(s * (1.f / 512.f) + EPS);
#pragma unroll 1
    for (int hb2 = 0; hb2 < 2; ++hb2) {
      u32x2 pc[32];
#pragma unroll
      for (int j = 0; j < 32; ++j) {
        const int h = hb2 * 4 + (j >> 3), qt = (j >> 2) & 1, dt = j & 3;
        pc[j] = *(const u32x2*)(WSP(u16, mixA) + (tq0 + wv * 32 + qt * 16 + l15) * 1024 + h * 64 + dt * 16 + quad * 4);
      }
#pragma unroll
      for (int j = 0; j < 32; ++j) {
        const int h = hb2 * 4 + (j >> 3), qt = (j >> 2) & 1, dt = j & 3;
        const float r = qt ? r1 : r0;
        f32x4 o = mkf4(bflo(pc[j].x) * r, bfhi(pc[j].x) * r, bflo(pc[j].y) * r, bfhi(pc[j].y) * r);
        *(u32x2*)(WSP(u16, mixA) + (tq0 + wv * 32 + qt * 16 + l15) * 1024 + h * 64 + dt * 16 + quad * 4) = pack4(o);
      }
    }
  }
}

DI void dn_conv_load(const Params& p, int type, int h, int c, size_t t0, int tid, u32x4* raw) {
  const int rg = tid >> 4, cg = tid & 15;
  const u16* base = WSP(u16, proj) + 768 + type * 512 + h * 128 + cg * 8;
#pragma unroll
  for (int j = 0; j < 7; ++j) {
    int row = 4 * rg - 3 + j;
    int srow = c * 64 + row;
    size_t t = (srow >= 0) ? (size_t)((long)t0 + row) : t0;
    raw[j] = *(const u32x4*)(base + t * NP);
  }
}
DI void dn_conv_compute(const Params& p, int type, int h, int c, int tid, const u32x4* raw, float* F) {
  const int rg = tid >> 4, cg = tid & 15;
  const int ch = type * 512 + h * 128 + cg * 8;
  float w[4][8];
#pragma unroll
  for (int j = 0; j < 4; ++j) {
    f32x4 a = *(const f32x4*)(p.convw + j * 1536 + ch), b = *(const f32x4*)(p.convw + j * 1536 + ch + 4);
    w[j][0] = a.x; w[j][1] = a.y; w[j][2] = a.z; w[j][3] = a.w; w[j][4] = b.x; w[j][5] = b.y; w[j][6] = b.z; w[j][7] = b.w;
  }
  float x[7][8];
#pragma unroll
  for (int j = 0; j < 7; ++j) {
    unpack8(raw[j], x[j]);
    if (c * 64 + 4 * rg - 3 + j < 0) {
#pragma unroll
      for (int e = 0; e < 8; ++e) x[j][e] = 0.f;
    }
  }
#pragma unroll
  for (int r = 0; r < 4; ++r) {
    float y[8];
#pragma unroll
    for (int e = 0; e < 8; ++e) {
      float v = w[0][e] * x[r][e] + w[1][e] * x[r + 1][e] + w[2][e] * x[r + 2][e] + w[3][e] * x[r + 3][e];
      y[e] = v / (1.f + __expf(-v));
    }
    float* dst = F + (4 * rg + r) * 128 + cg * 8;
    *(f32x4*)dst = mkf4(y[0], y[1], y[2], y[3]);
    *(f32x4*)(dst + 4) = mkf4(y[4], y[5], y[6], y[7]);
  }
}
DI void dn_rownorm(const float* F, float* rn) {
  const int tid = opaque_tid();
  const int cc = tid >> 2, part = tid & 3;
  float s = 0.f;
#pragma unroll 8
  for (int i = 0; i < 32; ++i) { float v = F[cc * 128 + part * 32 + ((i + tid) & 31)]; s += v * v; }
  s += __shfl_xor(s, 1); s += __shfl_xor(s, 2);
  if (part == 0) rn[cc] = rsqrtf(s + EPS);
}

DI void dn_chunk_item(const Params& p, int ci, char* smem) {
  const int c = ci & 63, h = (ci >> 6) & 3, b = ci >> 8;
  float* F = (float*)smem;
  u16* kbf = (u16*)(smem + 32768);
  u16* qbf = kbf + 64 * 136;
  float* gcs = (float*)(smem + 32768 + 2 * 17408);
  float* bet = gcs + 64; float* rn = gcs + 128;
  const int tid = opaque_tid(), lane = tid & 63, wv = tid >> 6, l15 = lane & 15, quad = lane >> 4;
  const size_t t0 = (size_t)b * 4096 + (size_t)c * 64;
  float sol[64];
  u32x4 rawk[7], rawq[7], rawv[7];
  dn_conv_load(p, 1, h, c, t0, tid, rawk);
  dn_conv_load(p, 0, h, c, t0, tid, rawq);
  dn_conv_load(p, 2, h, c, t0, tid, rawv);
  __syncthreads();
  if (tid < 64) {
    float g = WSP(float, gate_g)[(t0 + tid) * 4 + h];
#pragma unroll
    for (int o = 1; o < 64; o <<= 1) { float n = __shfl_up(g, o); if (lane >= o) g += n; }
    gcs[tid] = g; bet[tid] = WSP(float, gate_b)[(t0 + tid) * 4 + h]; gcs[192 + tid] = __expf(g);
  }
  dn_conv_compute(p, 1, h, c, tid, rawk, F);
  __syncthreads();
  dn_rownorm(F, rn);
  __syncthreads();
  {
    const int d = tid & 127, half = tid >> 7;
#pragma unroll 8
    for (int i = 0; i < 32; ++i) { int cc = half * 32 + i; kbf[cc * 136 + d] = f2bf(F[cc * 128 + d] * rn[cc]); }
    if (tid >= 128) {
#pragma unroll
      for (int cc = 0; cc < 64; ++cc) sol[cc] = F[cc * 128 + d] * rn[cc] * bet[cc] * gcs[192 + cc];
    }
  }
  __syncthreads();
  dn_conv_compute(p, 0, h, c, tid, rawq, F);
  __syncthreads();
  dn_rownorm(F, rn);
  __syncthreads();
  {
    const int d = tid & 127, half = tid >> 7;
#pragma unroll 8
    for (int i = 0; i < 32; ++i) { int cc = half * 32 + i; qbf[cc * 136 + d] = f2bf(F[cc * 128 + d] * rn[cc] * 0.08838834764831845f); }
  }
  __syncthreads();
  dn_conv_compute(p, 2, h, c, tid, rawv, F);
  __syncthreads();
  if (tid < 128) {
#pragma unroll
    for (int cc = 0; cc < 64; ++cc) sol[cc] = F[cc * 128 + tid] * bet[cc];
  }
  __syncthreads();
  float* Mf = F;
  {
    bf16x8 kc[4], qc[4];
#pragma unroll
    for (int kk = 0; kk < 4; ++kk) {
      kc[kk] = *(const bf16x8*)(kbf + (wv * 16 + l15) * 136 + kk * 32 + quad * 8);
      qc[kk] = *(const bf16x8*)(qbf + (wv * 16 + l15) * 136 + kk * 32 + quad * 8);
    }
    const int ci_ = wv * 16 + l15;
    const float gci = gcs[ci_], bi = bet[ci_];
#pragma unroll
    for (int jt = 0; jt < 4; ++jt) {
      f32x4 akk = fzero(), aqk = fzero();
#pragma unroll
      for (int kk = 0; kk < 4; ++kk) {
        bf16x8 kj = *(const bf16x8*)(kbf + (jt * 16 + l15) * 136 + kk * 32 + quad * 8);
        akk = mfma16(kj, kc[kk], akk);
        aqk = mfma16(kj, qc[kk], aqk);
      }
      f32x4 m4, q4;
#pragma unroll
      for (int r = 0; r < 4; ++r) {
        int j = jt * 16 + quad * 4 + r;
        float dec = __expf(fminf(gci - gcs[j], 0.f));
        m4[r] = (ci_ > j) ? bi * akk[r] * dec : 0.f;
        q4[r] = (ci_ >= j) ? aqk[r] * dec : 0.f;
      }
      *(f32x4*)(Mf + ci_ * 64 + jt * 16 + quad * 4) = mkf4(m4[0], m4[1], m4[2], m4[3]);
      *(u32x2*)(WSP(u16, qk) + ((size_t)ci * 64 + ci_) * 64 + jt * 16 + quad * 4) = pack4(q4);
    }
  }
  __syncthreads();
  {
    const int d = tid & 127, half = tid >> 7;
#pragma unroll 8
    for (int i = 0; i < 32; ++i) {
      int cc = half * 32 + i;
      WSP(u16, qd)[(size_t)ci * 8192 + cc * 128 + d] = f2bf(bf2f(qbf[cc * 136 + d]) * gcs[192 + cc]);
    }
    const int c2 = tid & 63, dg = tid >> 6;
    const float e = __expf(gcs[63] - gcs[c2]);
#pragma unroll 8
    for (int i = 0; i < 32; ++i) {
      int dd = dg * 32 + i;
      WSP(u16, kdT)[(size_t)ci * 8192 + dd * 64 + c2] = f2bf(bf2f(kbf[c2 * 136 + dd]) * e);
    }
    if (tid == 0) WSP(float, cd)[ci] = __expf(gcs[63]);
  }
  __syncthreads();
  {
    u16* Xt = (u16*)(smem + 32768);
    float* Cs = F + 4096;
    const int col = tid;
    {
      u32x4* z = (u32x4*)(Xt + col * 72);
#pragma unroll
      for (int i = 0; i < 9; ++i) z[i] = mk4(0u, 0u, 0u, 0u);
    }
#pragma unroll
    for (int bi = 0; bi < 4; ++bi) {
      float c16[16];
#pragma unroll
      for (int r = 0; r < 16; ++r) c16[r] = 0.f;
      if (bi > 0) {
        const int nks = (bi == 3) ? 2 : 1;
        bf16x8 af[2];
#pragma unroll
        for (int ks = 0; ks < 2; ++ks) {
          if (ks < nks) {
            const float* mp = Mf + (16 * bi + l15) * 64 + ks * 32 + quad * 8;
            f32x4 m0 = *(const f32x4*)mp, m1 = *(const f32x4*)(mp + 4);
            const bool keep = (ks * 32 + quad * 8) < 16 * bi;
            if (!keep) { m0 = fzero(); m1 = fzero(); }
            af[ks] = as_frag(mk4(pk(m0[0], m0[1]), pk(m0[2], m0[3]), pk(m1[0], m1[1]), pk(m1[2], m1[3])));
          }
        }
#pragma unroll
        for (int ct = 0; ct < 4; ++ct) {
          const int cb = (wv * 4 + ct) * 16 + l15;
          f32x4 a = fzero();
#pragma unroll
          for (int ks = 0; ks < 2; ++ks) {
            if (ks < nks) {
              bf16x8 xb = *(const bf16x8*)(Xt + cb * 72 + ks * 32 + quad * 8);
              a = mfma16(af[ks], xb, a);
            }
          }
          *(f32x4*)(Cs + cb * 16 + quad * 4) = a;
        }
        asm volatile("s_waitcnt lgkmcnt(0)" ::: "memory");
#pragma unroll
        for (int q = 0; q < 4; ++q) {
          f32x4 cv = *(const f32x4*)(Cs + col * 16 + q * 4);
          c16[4 * q] = cv[0]; c16[4 * q + 1] = cv[1]; c16[4 * q + 2] = cv[2]; c16[4 * q + 3] = cv[3];
        }
      }
#pragma unroll
      for (int r = 0; r < 16; ++r) {
        const int cc = 16 * bi + r;
        float a = sol[cc] - c16[r];
#pragma unroll
        for (int j4 = 4 * bi; j4 < (cc + 3) / 4; ++j4) {
          f32x4 m = *(const f32x4*)(Mf + cc * 64 + j4 * 4);
          a -= m.x * sol[j4 * 4] + m.y * sol[j4 * 4 + 1] + m.z * sol[j4 * 4 + 2] + m.w * sol[j4 * 4 + 3];
        }
        sol[cc] = a;
      }
      if (bi < 3) {
        u32x4* xo = (u32x4*)(Xt + col * 72 + 16 * bi);
        xo[0] = mk4(pk(sol[16 * bi], sol[16 * bi + 1]), pk(sol[16 * bi + 2], sol[16 * bi + 3]), pk(sol[16 * bi + 4], sol[16 * bi + 5]),
                    pk(sol[16 * bi + 6], sol[16 * bi + 7]));
        xo[1] = mk4(pk(sol[16 * bi + 8], sol[16 * bi + 9]), pk(sol[16 * bi + 10], sol[16 * bi + 11]), pk(sol[16 * bi + 12], sol[16 * bi + 13]),
                    pk(sol[16 * bi + 14], sol[16 * bi + 15]));
        asm volatile("s_waitcnt lgkmcnt(0)" ::: "memory");
      }
    }
  }
  {
    u16* dst = (u16*)(p.ws + ((tid < 128) ? OFF_u_ : OFF_w_)) + (size_t)ci * 8192 + (tid & 127);
#pragma unroll
    for (int cc = 0; cc < 64; ++cc) dst[cc * 128] = f2bf(sol[cc]);
  }
}

struct ScanFrag { bf16x8 wf[4], qf[4], qkf[2], kf[2][2]; u32x2 uu; float cdv; };

DI void scan_load(const Params& p, int bh, int s, int sl, ScanFrag& f) {
  const int tid_ = opaque_tid(); const int lane = tid_ & 63, wv = tid_ >> 6, l15 = lane & 15, quad = lane >> 4;
  const size_t ci = (size_t)bh * 64 + s;
  const u16* wb = WSP(u16, w_) + ci * 8192 + (wv * 16 + l15) * 128 + quad * 8;
  const u16* qb = WSP(u16, qd) + ci * 8192 + (wv * 16 + l15) * 128 + quad * 8;
#pragma unroll
  for (int kk = 0; kk < 4; ++kk) { f.wf[kk] = *(const bf16x8*)(wb + kk * 32); f.qf[kk] = *(const bf16x8*)(qb + kk * 32); }
  const u16* qkb = WSP(u16, qk) + ci * 4096 + (wv * 16 + l15) * 64 + quad * 8;
#pragma unroll
  for (int k2 = 0; k2 < 2; ++k2) f.qkf[k2] = *(const bf16x8*)(qkb + k2 * 32);
#pragma unroll
  for (int dt = 0; dt < 2; ++dt)
#pragma unroll
    for (int k2 = 0; k2 < 2; ++k2)
      f.kf[dt][k2] = *(const bf16x8*)(WSP(u16, kdT) + ci * 8192 + ((2 * wv + dt) * 16 + l15) * 64 + k2 * 32 + quad * 8);
  f.uu = *(const u32x2*)(WSP(u16, u_) + ci * 8192 + (wv * 16 + l15) * 128 + sl * 16 + quad * 4);
  f.cdv = WSP(float, cd)[ci];
}

DI void dn_scan_item(const Params& p, int item, char* smem) {
  const int bh = (item & 7) + 8 * (item >> 6), sl = (item >> 3) & 7;
  const int b = bh >> 2, h = bh & 3;
  u16* St = (u16*)smem;
  u16* vnT = St + 16 * 136;
  const int tid = opaque_tid(), lane = tid & 63, wv = tid >> 6, l15 = lane & 15, quad = lane >> 4;
  __syncthreads();
  for (int i = tid; i < 16 * 136; i += 256) St[i] = 0;
  f32x4 Sacc[2] = {fzero(), fzero()};
  ScanFrag fa, fb, fc;
  scan_load(p, bh, 0, sl, fa);
  scan_load(p, bh, 1, sl, fb);
  __syncthreads();
  auto step = [&](const ScanFrag& cur, int s) {
    bf16x8 sa[4];
#pragma unroll
    for (int kk = 0; kk < 4; ++kk) sa[kk] = *(const bf16x8*)(St + l15 * 136 + kk * 32 + quad * 8);
    f32x4 av = fzero(), ao = fzero();
#pragma unroll
    for (int kk = 0; kk < 4; ++kk) { av = mfma16(sa[kk], cur.wf[kk], av); ao = mfma16(sa[kk], cur.qf[kk], ao); }
    float vn[4];
    vn[0] = bflo(cur.uu.x) - av[0]; vn[1] = bfhi(cur.uu.x) - av[1];
    vn[2] = bflo(cur.uu.y) - av[2]; vn[3] = bfhi(cur.uu.y) - av[3];
#pragma unroll
    for (int r = 0; r < 4; ++r) vnT[(quad * 4 + r) * 72 + wv * 16 + l15] = f2bf(vn[r]);
    lds_barrier();
    bf16x8 va[2];
#pragma unroll
    for (int k2 = 0; k2 < 2; ++k2) va[k2] = *(const bf16x8*)(vnT + l15 * 72 + k2 * 32 + quad * 8);
#pragma unroll
    for (int k2 = 0; k2 < 2; ++k2) ao = mfma16(va[k2], cur.qkf[k2], ao);
    {
      size_t t = (size_t)b * 4096 + (size_t)s * 64 + wv * 16 + l15;
      *(u32x2*)(WSP(u16, mixA) + t * 1024 + 512 + h * 128 + sl * 16 + quad * 4) = pack4(ao);
    }
#pragma unroll
    for (int dt = 0; dt < 2; ++dt) {
      f32x4 sv = Sacc[dt];
      sv[0] *= cur.cdv; sv[1] *= cur.cdv; sv[2] *= cur.cdv; sv[3] *= cur.cdv;
#pragma unroll
      for (int k2 = 0; k2 < 2; ++k2) sv = mfma16(va[k2], cur.kf[dt][k2], sv);
      Sacc[dt] = sv;
#pragma unroll
      for (int r = 0; r < 4; ++r) St[(quad * 4 + r) * 136 + (2 * wv + dt) * 16 + l15] = f2bf(sv[r]);
    }
    lds_barrier();
  };
  for (int s = 0; s < 63; s += 3) {
    scan_load(p, bh, s + 2, sl, fc);
    step(fa, s);
    scan_load(p, bh, min(s + 3, 63), sl, fa);
    step(fb, s + 1);
    scan_load(p, bh, min(s + 4, 63), sl, fb);
    step(fc, s + 2);
  }
  step(fa, 63);
}

DI unsigned enc_f(float f) { unsigned u = __float_as_uint(f); return (u & 0x80000000u) ? ~u : (u | 0x80000000u); }
DI float dec_f(unsigned k) { unsigned u = (k & 0x80000000u) ? (k ^ 0x80000000u) : ~k; return __uint_as_float(u); }

DI void p4_gemm2(const Params& p, int tile, char* smem) {
  const int tid = opaque_tid(), lane = tid & 63, wv = tid >> 6, l15 = lane & 15, quad = lane >> 4;
  const size_t t0 = (size_t)tile * 128;
  float* ssq_l = (float*)(smem + 74752);
  __syncthreads();
  if (tid < 128) ssq_l[tid] = 0.f;
  for (int i0 = 0; i0 < 32; i0 += 4) {
    const int cc = tid & 63;
    u32x4 rd[4], rz[4];
#pragma unroll
    for (int i = 0; i < 4; ++i) {
      size_t t = t0 + (tid >> 6) + 4 * (i0 + i);
      rd[i] = *(const u32x4*)(WSP(u16, mixA) + t * 1024 + 512 + cc * 8);
      rz[i] = *(const u32x4*)(WSP(u16, proj) + t * NP + 2304 + cc * 8);
    }
#pragma unroll
    for (int i = 0; i < 4; ++i) {
      size_t t = t0 + (tid >> 6) + 4 * (i0 + i);
      float f[8], z[8];
      unpack8(rd[i], f); unpack8(rz[i], z);
      float sq = 0.f;
#pragma unroll
      for (int e = 0; e < 8; ++e) sq += f[e] * f[e];
#pragma unroll
      for (int m = 1; m < 16; m <<= 1) sq += __int_as_float(__builtin_amdgcn_ds_bpermute((cc ^ m) << 2, __float_as_int(sq)));
      float r = rsqrtf(sq * (1.f / 128.f) + EPS);
#pragma unroll
      for (int e = 0; e < 8; ++e) f[e] = f[e] * r * p.g_o[(cc & 15) * 8 + e] * (z[e] / (1.f + __expf(-z[e])));
      *(u32x4*)(WSP(u16, mixA) + t * 1024 + 512 + cc * 8) = pack8(f);
    }
  }
  __syncthreads();
  {
    for (int nc = 0; nc < 4; ++nc) {
      float ssq[8] = {0.f, 0.f, 0.f, 0.f, 0.f, 0.f, 0.f, 0.f};
      gemm_tile(WSP(u16, mixA) + t0 * 1024, WSP(u16, WoutT) + (size_t)nc * 256 * 1024, smem,
        [&](int tt, int ft, int wv, int l15, int quad) {
        size_t t = t0 + tt * 16 + l15; int n = nc * 256 + wv * 64 + ft * 16 + quad * 4;
        return *(const f32x4*)(p.x + t * 1024 + n);
      },
        [&](int tt, int ft, f32x4 v, f32x4 xv, int wv, int l15, int quad) {
        size_t t = t0 + tt * 16 + l15; int n = nc * 256 + wv * 64 + ft * 16 + quad * 4;
        f32x4 hv = xv + v;
        *(u32x2*)(WSP(u16, hb) + t * 1024 + n) = pack4(hv);
        ssq[tt] += hv[0] * hv[0] + hv[1] * hv[1] + hv[2] * hv[2] + hv[3] * hv[3];
      });
      {
        const int t2 = opaque_tid(); const int ln = t2 & 63, l15b = ln & 15, qdb = ln >> 4;
#pragma unroll
        for (int tt = 0; tt < 8; ++tt) {
          float sv = ssq[tt];
          sv += __int_as_float(__builtin_amdgcn_ds_bpermute((ln ^ 16) << 2, __float_as_int(sv)));
          sv += __int_as_float(__builtin_amdgcn_ds_bpermute((ln ^ 32) << 2, __float_as_int(sv)));
          if (qdb == 0) atomicAdd(&ssq_l[tt * 16 + l15b], sv);
        }
      }
    }
  }
  __syncthreads();
  {
    const int t3 = opaque_tid();
    if (t3 < 128) WSP(float, rstd2)[t0 + t3] = rsqrtf(ssq_l[t3] * (1.f / 1024.f) + EPS);
  }
}

DI void p4_gemm3(const Params& p, int tile, char* smem) {
  const int tid = opaque_tid(), lane = tid & 63, wv = tid >> 6, l15 = lane & 15, quad = lane >> 4;
  const size_t t0 = (size_t)tile * 128;
  for (int nc = 0; nc < 4; ++nc) {
    gemm_tile(WSP(u16, hb) + t0 * 1024, WSP(u16, WqT) + (size_t)nc * 256 * 1024, smem,
      [&](int tt, int ft, int wv, int l15, int quad) { return mkf4(WSP(float, rstd2)[t0 + tt * 16 + l15], 0.f, 0.f, 0.f); },
      [&](int tt, int ft, f32x4 v, f32x4 pvv, int wv, int l15, int quad) {
      int tl = tt * 16 + l15; size_t t = t0 + tl; int n = nc * 256 + wv * 64 + ft * 16 + quad * 4;
      float r = pvv[0];
      v[0] *= r; v[1] *= r; v[2] *= r; v[3] *= r;
      *(u32x2*)(WSP(u16, qp) + t * 1024 + n) = pack4(v);
    });
  }
}

DI void bitonic_sort16_desc(unsigned* a) {
#pragma unroll
  for (int k = 2; k <= 16; k <<= 1)
#pragma unroll
    for (int j = k >> 1; j > 0; j >>= 1)
#pragma unroll
      for (int i = 0; i < 16; ++i) {
        const int l = i ^ j;
        if (l > i) {
          const bool desc = ((i & k) == 0);
          const unsigned hi = max(a[i], a[l]), lo = min(a[i], a[l]);
          a[i] = desc ? hi : lo; a[l] = desc ? lo : hi;
        }
      }
}
DI void merge_top16(unsigned* a, const unsigned* b) {
#pragma unroll
  for (int i = 0; i < 16; ++i) a[i] = max(a[i], b[15 - i]);
#pragma unroll
  for (int j = 8; j > 0; j >>= 1)
#pragma unroll
    for (int i = 0; i < 16; ++i) {
      const int l = i ^ j;
      if (l > i) { const unsigned hi = max(a[i], a[l]), lo = min(a[i], a[l]); a[i] = hi; a[l] = lo; }
    }
}

constexpr unsigned char PEER_CAND[52] = {0, 1, 2, 3, 4, 5, 6, 7, 8, 9, 10, 11, 12, 13, 14, 15, 16, 17, 18, 19, 20, 21, 22, 23, 32, 33, 34, 35, 36, 48, 49, 50, 51, 64, 65, 66, 80, 81, 96, 97, 112, 113, 128, 144, 160, 176, 192, 208, 224, 240, 255, 255};

DI void p4_peer(const Params& p, int tile, char* smem) {
  const int tid = opaque_tid(), lane = tid & 63, wv = tid >> 6, l15 = lane & 15, quad = lane >> 4;
  const size_t t0 = (size_t)tile * 64;
  float* scb = (float*)smem;
  unsigned* tk = (unsigned*)(smem + 66048);
  float* rstd2 = (float*)(smem + 74752);
  __syncthreads();
  if (tid < 64) rstd2[tid] = WSP(float, rstd2)[t0 + tid];
  for (int h = 0; h < 8; ++h) {
    __syncthreads();
#pragma unroll
    for (int pp = 0; pp < 2; ++pp) {
      const u16* qrow = WSP(u16, qp) + (t0 + wv * 16 + l15) * 1024 + h * 128 + pp * 64 + quad * 8;
      bf16x8 tf0 = *(const bf16x8*)qrow, tf1 = *(const bf16x8*)(qrow + 32);
      const int list = (wv * 16 + l15) * 2 + pp;
#pragma unroll
      for (int nt = 0; nt < 8; ++nt) {
        const u16* krow = WSP(u16, keysb) + ((size_t)((h * 2 + pp) * 128) + nt * 16 + l15) * 64 + quad * 8;
        bf16x8 k0 = *(const bf16x8*)krow, k1 = *(const bf16x8*)(krow + 32);
        f32x4 a = fzero();
        a = mfma16(k0, tf0, a); a = mfma16(k1, tf1, a);
#pragma unroll
        for (int r = 0; r < 4; ++r) scb[list * 129 + nt * 16 + quad * 4 + r] = a[r];
      }
    }
    __syncthreads();
    {
      const int list = tid >> 1, half = tid & 1;
      unsigned best[16];
#pragma unroll
      for (int g = 0; g < 4; ++g) {
        unsigned cur[16];
#pragma unroll
        for (int i = 0; i < 16; ++i) {
          const int n = half * 64 + g * 16 + i;
          cur[i] = (enc_f(scb[list * 129 + n]) & ~127u) | (unsigned)n;
        }
        bitonic_sort16_desc(cur);
        if (g == 0) {
#pragma unroll
          for (int i = 0; i < 16; ++i) best[i] = cur[i];
        } else merge_top16(best, cur);
      }
      unsigned oth[16];
#pragma unroll
      for (int i = 0; i < 16; ++i) oth[i] = (unsigned)__shfl_xor((int)best[i], 1);
      merge_top16(best, oth);
      if (half == 0) {
#pragma unroll
        for (int i = 0; i < 16; ++i) tk[list * 17 + i] = best[i];
      }
    }
    __syncthreads();
    {
      const int tok = tid >> 2, role = tid & 3;
      const unsigned* ta = tk + (tok * 2) * 17;
      const unsigned* tb = tk + (tok * 2 + 1) * 17;
      unsigned top[16];
#pragma unroll
      for (int m = 0; m < 13; ++m) {
        const unsigned c0 = PEER_CAND[4 * m], c1 = PEER_CAND[4 * m + 1], c2 = PEER_CAND[4 * m + 2], c3 = PEER_CAND[4 * m + 3];
        const unsigned code = (role == 0) ? c0 : (role == 1) ? c1 : (role == 2) ? c2 : c3;
        const bool ok = code != 255u;
        const unsigned cc = ok ? code : 0u;
        const float sa = dec_f(ta[cc >> 4] & ~127u), sb = dec_f(tb[cc & 15u] & ~127u);
        top[m] = ok ? ((enc_f(sa + sb) & ~255u) | cc) : 0u;
      }
      top[13] = 0u; top[14] = 0u; top[15] = 0u;
      bitonic_sort16_desc(top);
      unsigned oth[16];
#pragma unroll
      for (int i = 0; i < 16; ++i) oth[i] = (unsigned)__shfl_xor((int)top[i], 1);
      merge_top16(top, oth);
#pragma unroll
      for (int i = 0; i < 16; ++i) oth[i] = (unsigned)__shfl_xor((int)top[i], 2);
      merge_top16(top, oth);
      const float mx = dec_f(top[0] & ~255u);
      unsigned mine[4]; float ev[4]; float sum = 0.f;
#pragma unroll
      for (int mm = 0; mm < 4; ++mm) {
        mine[mm] = (role == 0) ? top[mm] : (role == 1) ? top[4 + mm] : (role == 2) ? top[8 + mm] : top[12 + mm];
        ev[mm] = __expf(dec_f(mine[mm] & ~255u) - mx); sum += ev[mm];
      }
      sum += __shfl_xor(sum, 1); sum += __shfl_xor(sum, 2);
      const float isum = 1.f / sum;
      const size_t t = t0 + tok;
#pragma unroll
      for (int mm = 0; mm < 4; ++mm) {
        const unsigned code = mine[mm] & 255u;
        const unsigned ia = ta[code >> 4] & 127u, ib = tb[code & 15u] & 127u;
        WSP(int, pidx)[t * 128 + h * 16 + role * 4 + mm] = (int)(ia * 128u + ib);
        WSP(float, pgate)[t * 128 + h * 16 + role * 4 + mm] = ev[mm] * isum;
      }
    }
  }
  __syncthreads();
  u32x4 nh0, nh1; int nid0, nid1; float ng0, ng1;
  {
    const size_t t = t0 + wv * 16;
    const u32x4* hrow = (const u32x4*)(WSP(u16, hb) + t * 1024);
    nh0 = hrow[lane * 2]; nh1 = hrow[lane * 2 + 1];
    nid0 = WSP(int, pidx)[t * 128 + lane]; nid1 = WSP(int, pidx)[t * 128 + 64 + lane];
    ng0 = WSP(float, pgate)[t * 128 + lane]; ng1 = WSP(float, pgate)[t * 128 + 64 + lane];
  }
  for (int tt = 0; tt < 16; ++tt) {
    const int tl = wv * 16 + tt; const size_t t = t0 + tl;
    const float rs = rstd2[tl];
    const u32x4 ch0 = nh0, ch1 = nh1;
    const int id0 = nid0, id1 = nid1; const float g0 = ng0, g1 = ng1;
    {
      const size_t tn = t0 + wv * 16 + min(tt + 1, 15);
      const u32x4* hrow = (const u32x4*)(WSP(u16, hb) + tn * 1024);
      nh0 = hrow[lane * 2]; nh1 = hrow[lane * 2 + 1];
      nid0 = WSP(int, pidx)[tn * 128 + lane]; nid1 = WSP(int, pidx)[tn * 128 + 64 + lane];
      ng0 = WSP(float, pgate)[tn * 128 + lane]; ng1 = WSP(float, pgate)[tn * 128 + 64 + lane];
    }
    float xf[16]; unpack8(ch0, xf); unpack8(ch1, xf + 8);
    float xm = 0.f;
#pragma unroll
    for (int i = 0; i < 16; ++i) xm = fmaxf(xm, fabsf(xf[i]));
#pragma unroll
    for (int o = 32; o > 0; o >>= 1) xm = fmaxf(xm, __shfl_xor(xm, o));
    xm = fmaxf(xm, 1e-30f);
    const float xinv = 127.f / xm;
    const float sxrs = xm * (1.f / 127.f) * rs;
    int xq[4];
#pragma unroll
    for (int i = 0; i < 4; ++i) {
      unsigned b0 = (unsigned)(int)rintf(xf[4 * i] * xinv) & 0xffu, b1 = (unsigned)(int)rintf(xf[4 * i + 1] * xinv) & 0xffu;
      unsigned b2 = (unsigned)(int)rintf(xf[4 * i + 2] * xinv) & 0xffu, b3 = (unsigned)(int)rintf(xf[4 * i + 3] * xinv) & 0xffu;
      xq[i] = (int)(b0 | (b1 << 8) | (b2 << 16) | (b3 << 24));
    }
    float acc[16];
#pragma unroll
    for (int i = 0; i < 16; ++i) acc[i] = 0.f;
    float corr = 0.f;
    u32x4 ua[4], va[4]; float gt[4], su[4], sv[4];
    u32x4 nua[4], nva[4]; float ngt[4], nsu[4], nsv[4];
#pragma unroll
    for (int j = 0; j < 4; ++j) {
      const int e = __builtin_amdgcn_readlane(id0, j);
      gt[j] = __uint_as_float(__builtin_amdgcn_readlane(__float_as_uint(g0), j));
      ua[j] = ((const u32x4*)(p.ws + OFF_ub))[(size_t)e * 128 + lane];
      va[j] = ((const u32x4*)(p.ws + OFF_ub))[(size_t)e * 128 + 64 + lane];
      su[j] = WSP(float, us)[e]; sv[j] = WSP(float, vs)[e];
    }
    for (int k0 = 0; k0 < 128; k0 += 4) {
      {
        const int kn = min(k0 + 4, 124);
        const int ids = (kn < 64) ? id0 : id1; const float gs = (kn < 64) ? g0 : g1;
#pragma unroll
        for (int j = 0; j < 4; ++j) {
          const int e = __builtin_amdgcn_readlane(ids, (kn + j) & 63);
          ngt[j] = __uint_as_float(__builtin_amdgcn_readlane(__float_as_uint(gs), (kn + j) & 63));
          nua[j] = ((const u32x4*)(p.ws + OFF_ub))[(size_t)e * 128 + lane];
          nva[j] = ((const u32x4*)(p.ws + OFF_ub))[(size_t)e * 128 + 64 + lane];
          nsu[j] = WSP(float, us)[e]; nsv[j] = WSP(float, vs)[e];
        }
      }
      int d[4];
#pragma unroll
      for (int j = 0; j < 4; ++j) {
        int a = 0;
#pragma unroll
        for (int i = 0; i < 4; ++i) a = __builtin_amdgcn_sdot4((int)ua[j][i], xq[i], a, false);
        d[j] = a;
      }
      const bool b0 = lane & 1, b1 = lane & 2;
      int k0v = b0 ? d[1] : d[0], s0v = b0 ? d[0] : d[1];
      int k1v = b0 ? d[3] : d[2], s1v = b0 ? d[2] : d[3];
      k0v += __shfl_xor(s0v, 1); k1v += __shfl_xor(s1v, 1);
      int kv = b1 ? k1v : k0v, sv2 = b1 ? k0v : k1v;
      kv += __shfl_xor(sv2, 2);
      kv += __shfl_xor(kv, 4); kv += __shfl_xor(kv, 8); kv += __shfl_xor(kv, 16); kv += __shfl_xor(kv, 32);
      const int jm = lane & 3;
      const float su_l = (jm == 0) ? su[0] : (jm == 1) ? su[1] : (jm == 2) ? su[2] : su[3];
      const float sv_l = (jm == 0) ? sv[0] : (jm == 1) ? sv[1] : (jm == 2) ? sv[2] : sv[3];
      const float gt_l = (jm == 0) ? gt[0] : (jm == 1) ? gt[1] : (jm == 2) ? gt[2] : gt[3];
      const float pre = (float)kv * su_l * sxrs;
      const float a_l = 0.5f * pre * (1.f + erff(pre * 0.70710678118654752f)) * gt_l * sv_l;
#pragma unroll
      for (int j = 0; j < 4; ++j) {
        const float a = __uint_as_float(__builtin_amdgcn_readlane(__float_as_uint(a_l), j));
        corr += a;
#pragma unroll
        for (int i = 0; i < 4; ++i) {
          const unsigned wd = va[j][i];
          acc[4 * i] += a * (float)(wd & 0xffu); acc[4 * i + 1] += a * (float)((wd >> 8) & 0xffu);
          acc[4 * i + 2] += a * (float)((wd >> 16) & 0xffu); acc[4 * i + 3] += a * (float)(wd >> 24);
        }
      }
#pragma unroll
      for (int j = 0; j < 4; ++j) { ua[j] = nua[j]; va[j] = nva[j]; gt[j] = ngt[j]; su[j] = nsu[j]; sv[j] = nsv[j]; }
    }
    const float c128 = 128.f * corr;
    float hf[16]; unpack8(ch0, hf); unpack8(ch1, hf + 8);
    f32x4* orow = (f32x4*)(p.out + t * 1024) + lane * 4;
#pragma unroll
    for (int i = 0; i < 4; ++i)
      orow[i] = mkf4(hf[4 * i] + acc[4 * i] - c128, hf[4 * i + 1] + acc[4 * i + 1] - c128, hf[4 * i + 2] + acc[4 * i + 2] - c128,
                     hf[4 * i + 3] + acc[4 * i + 3] - c128);
  }
}

DI void grid_barrier(unsigned* ctr, unsigned target) {
  __syncthreads();
  if (threadIdx.x == 0) {
    __builtin_amdgcn_fence(__ATOMIC_RELEASE, "agent");
    asm volatile("s_waitcnt vmcnt(0)" ::: "memory");
    __hip_atomic_fetch_add(ctr, 1u, __ATOMIC_RELAXED, __HIP_MEMORY_SCOPE_AGENT);
    while (__hip_atomic_load(ctr, __ATOMIC_RELAXED, __HIP_MEMORY_SCOPE_AGENT) < target) __builtin_amdgcn_s_sleep(2);
    __builtin_amdgcn_fence(__ATOMIC_ACQUIRE, "agent");
    asm volatile("s_waitcnt vmcnt(0)" ::: "memory");
  }
  __syncthreads();
}

#ifndef NOMAIN
__global__ void __launch_bounds__(256, 2) hybrid_megakernel(Params p) {
  __shared__ __attribute__((aligned(16))) char smem[SMEM_BYTES];
  cg::grid_group grid = cg::this_grid();
  unsigned* bar = (unsigned*)(p.ws + OFF_bar);
  if (blockIdx.x == 0 && threadIdx.x == 0) __hip_atomic_store(bar, 0u, __ATOMIC_RELAXED, __HIP_MEMORY_SCOPE_AGENT);
  phase0(p, smem);
  grid.sync();
  phase1(p, smem);
  grid_barrier(bar, gridDim.x);
  for (int item = blockIdx.x; item < 512; item += gridDim.x) attn_item(p, item, smem);
  for (int item = blockIdx.x; item < 4096; item += gridDim.x) dn_chunk_item(p, item, smem);
  grid_barrier(bar, 2 * gridDim.x);
  for (int item = blockIdx.x; item < 512; item += gridDim.x) dn_scan_item(p, item, smem);
  grid_barrier(bar, 3 * gridDim.x);
  for (int tile = blockIdx.x; tile < 512; tile += gridDim.x) p4_gemm2(p, tile, smem);
  __syncthreads();
  for (int tile = blockIdx.x; tile < 512; tile += gridDim.x) p4_gemm3(p, tile, smem);
  __syncthreads();
  for (int tile = blockIdx.x; tile < 512; tile += gridDim.x) { p4_peer(p, 2 * tile, smem); p4_peer(p, 2 * tile + 1, smem); }
}

extern "C" void kernel_launch(void* const* d_in, const int* in_sizes, int n_in, void* d_out, int out_size, void* d_ws, size_t ws_size,
                              hipStream_t stream) {
  static int grid_blocks = 0;
  if (!grid_blocks) {
    int dev = 0, cus = 0, per_cu = 0;
    hipGetDevice(&dev);
    hipDeviceGetAttribute(&cus, hipDeviceAttributeMultiprocessorCount, dev);
    hipOccupancyMaxActiveBlocksPerMultiprocessor(&per_cu, hybrid_megakernel, 256, 0);
    if (per_cu > 2) per_cu = 2;
    grid_blocks = cus * per_cu;
  }
  Params p{};
  p.x = (const float*)d_in[0]; p.g1 = (const float*)d_in[1]; p.w_in = (const float*)d_in[2]; p.gq = (const float*)d_in[3];
  p.gk = (const float*)d_in[4]; p.sinks = (const float*)d_in[5]; p.g_att = (const float*)d_in[6]; p.convw = (const float*)d_in[7];
  p.a_log = (const float*)d_in[8]; p.dt_bias = (const float*)d_in[9]; p.g_o = (const float*)d_in[10]; p.w_out = (const float*)d_in[11];
  p.g_ffn = (const float*)d_in[12]; p.w_q = (const float*)d_in[13]; p.keys = (const float*)d_in[14]; p.pu = (const float*)d_in[15];
  p.pv = (const float*)d_in[16];
  p.out = (float*)d_out;
  p.ws = (char*)d_ws;
  if (WS_TOTAL > ws_size) { fprintf(stderr, "workspace too small: need %zu have %zu\n", (size_t)WS_TOTAL, ws_size); return; }
  void* args[] = {&p};
  hipError_t e = hipLaunchCooperativeKernel((void*)hybrid_megakernel, dim3(grid_blocks), dim3(256), args, 0, stream);
  if (e != hipSuccess) fprintf(stderr, "cooperative launch failed: %s (grid %d)\n", hipGetErrorString(e), grid_blocks);
}
#endif
```

```cpp
#include <hip/hip_runtime.h>
#include <hip/hip_cooperative_groups.h>
#include <cstdio>
namespace cg = cooperative_groups;

#define DI __device__ __forceinline__
typedef unsigned short u16;
typedef __attribute__((ext_vector_type(8))) short bf16x8;
typedef __attribute__((ext_vector_type(4))) float f32x4;
typedef __attribute__((ext_vector_type(4))) unsigned u32x4;
typedef __attribute__((ext_vector_type(2))) unsigned u32x2;

constexpr int T = 65536;
constexpr int NP = 2816;
constexpr int SMEM_BYTES = 75776;
constexpr float EPS = 1e-6f;

struct Params {
  const float *x, *g1, *w_in, *gq, *gk, *sinks, *g_att, *convw, *a_log, *dt_bias, *g_o, *w_out, *g_ffn, *w_q, *keys, *pu, *pv;
  float* out;
  char* ws;
};
constexpr size_t MiB = 1024 * 1024;
constexpr size_t OFF_mixA = 0, OFF_proj = 128 * MiB, OFF_u_ = 480 * MiB, OFF_w_ = 544 * MiB, OFF_qd = 608 * MiB, OFF_kdT = 672 * MiB,
                 OFF_qk = 736 * MiB, OFF_ub = 768 * MiB, OFF_vb = 800 * MiB, OFF_WinT = 832 * MiB, OFF_WoutT = 838 * MiB, OFF_WqT = 840 * MiB,
                 OFF_keysb = 842 * MiB, OFF_pgate = 843 * MiB, OFF_rstd1 = 875 * MiB, OFF_rstd_att = 876 * MiB, OFF_rstd2 = 876 * MiB + 524288, OFF_gate_g = 877 * MiB,
                 OFF_gate_b = 878 * MiB, OFF_cd = 879 * MiB, OFF_bar = 879 * MiB + 32768, OFF_us = 879 * MiB + 65536, OFF_vs = 879 * MiB + 131072, WS_TOTAL = 880 * MiB;
constexpr size_t OFF_hb = OFF_u_, OFF_qp = OFF_qd, OFF_pidx = OFF_qk;
#define WSP(type, name) ((type*)(p.ws + OFF_##name))

DI int opaque_tid() { int t = threadIdx.x; asm volatile("" : "+v"(t)); return t; }
DI void lds_barrier() { asm volatile("s_waitcnt lgkmcnt(0)\n\ts_barrier" ::: "memory"); }
DI u32x4 mk4(unsigned a, unsigned b, unsigned c, unsigned d) { u32x4 r = {a, b, c, d}; return r; }
DI u32x2 mk2(unsigned a, unsigned b) { u32x2 r = {a, b}; return r; }
DI f32x4 mkf4(float a, float b, float c, float d) { f32x4 r = {a, b, c, d}; return r; }
typedef __bf16 bf16x2_t __attribute__((ext_vector_type(2)));
DI u16 f2bf(float f) { __bf16 v = (__bf16)f; return __builtin_bit_cast(u16, v); }
DI float bf2f(u16 h) { return __uint_as_float(((unsigned)h) << 16); }
DI unsigned pk(float a, float b) { bf16x2_t v = {(__bf16)a, (__bf16)b}; return __builtin_bit_cast(unsigned, v); }
DI float bflo(unsigned u) { return __uint_as_float(u << 16); }
DI float bfhi(unsigned u) { return __uint_as_float(u & 0xffff0000u); }
DI f32x4 mfma16(bf16x8 a, bf16x8 b, f32x4 c) { return __builtin_amdgcn_mfma_f32_16x16x32_bf16(a, b, c, 0, 0, 0); }
DI float wsum(float v) {
#pragma unroll
  for (int o = 32; o > 0; o >>= 1) v += __shfl_xor(v, o);
  return v;
}
DI void unpack8(u32x4 v, float* f) {
  f[0] = bflo(v.x); f[1] = bfhi(v.x); f[2] = bflo(v.y); f[3] = bfhi(v.y);
  f[4] = bflo(v.z); f[5] = bfhi(v.z); f[6] = bflo(v.w); f[7] = bfhi(v.w);
}
DI u32x4 pack8(const float* f) { return mk4(pk(f[0], f[1]), pk(f[2], f[3]), pk(f[4], f[5]), pk(f[6], f[7])); }
DI bf16x8 as_frag(u32x4 v) { return __builtin_bit_cast(bf16x8, v); }
DI u32x2 pack4(f32x4 v) { return mk2(pk(v[0], v[1]), pk(v[2], v[3])); }
DI f32x4 fzero() { f32x4 z = {0.f, 0.f, 0.f, 0.f}; return z; }

DI void transpose_tile(const float* __restrict__ src, int ld, int col0, const float* __restrict__ scale, u16* __restrict__ dst,
                       int kt, int nt, float* tl) {
  const int tid = threadIdx.x;
  __syncthreads();
  float tv[16];
#pragma unroll
  for (int i = 0; i < 16; ++i) {
    int r = i * 4 + (tid >> 6), c = tid & 63;
    int k = kt * 64 + r;
    float s = scale ? scale[k] : 1.f;
    tv[i] = src[(size_t)k * ld + col0 + c] * s;
  }
#pragma unroll
  for (int i = 0; i < 16; ++i) { int r = i * 4 + (tid >> 6), c = tid & 63; tl[r * 65 + c] = tv[i]; }
  __syncthreads();
#pragma unroll 4
  for (int i = 0; i < 16; ++i) {
    int n = i * 4 + (tid >> 6), k = tid & 63;
    const int ng = nt * 64 + n, kg = kt * 64 + k;
    dst[((size_t)((ng >> 4) * 32 + (kg >> 5)) * 64 + ((kg >> 3) & 3) * 16 + (ng & 15)) * 8 + (kg & 7)] = f2bf(tl[k * 65 + n]);
  }
}

DI void phase0(const Params& p, char* smem) {
  const int tid = opaque_tid(), lane = tid & 63, wv = tid >> 6;
  {
    float* tl = (float*)smem;
    for (int tile = blockIdx.x; tile < 1216; tile += gridDim.x) {
      if (tile < 704) {
        int kt = tile / 44, nt = tile % 44;
        int n0 = nt * 64;
        int col0 = (n0 < 2304) ? n0 : n0 + 8;
        transpose_tile(p.w_in, 2824, col0, p.g1, WSP(u16, WinT), kt, nt, tl);
      } else if (tile < 960) {
        int t2 = tile - 704; int kt = t2 >> 4, nt = t2 & 15;
        transpose_tile(p.w_out, 1024, nt * 64, (kt < 8) ? p.g_att : nullptr, WSP(u16, WoutT), kt, nt, tl);
      } else {
        int t2 = tile - 960; int kt = t2 >> 4, nt = t2 & 15;
        transpose_tile(p.w_q, 1024, nt * 64, p.g_ffn, WSP(u16, WqT), kt, nt, tl);
      }
    }
    __syncthreads();
  }
  {
    const int gw = blockIdx.x * 4 + wv, nw = gridDim.x * 4;
    f32x4 v[4], vn[4];
    if (gw < 32768) {
      const f32x4* src = (const f32x4*)(((gw < 16384) ? p.pu : p.pv) + (size_t)(gw & 16383) * 1024);
#pragma unroll
      for (int i = 0; i < 4; ++i) v[i] = src[lane * 4 + i];
    }
    for (int row = gw; row < 32768; row += nw) {
      const bool isu = row < 16384;
      const int e = row & 16383;
      {
        const int rn = min(row + nw, 32767);
        const f32x4* srcn = (const f32x4*)(((rn < 16384) ? p.pu : p.pv) + (size_t)(rn & 16383) * 1024);
#pragma unroll
        for (int i = 0; i < 4; ++i) vn[i] = srcn[lane * 4 + i];
      }
#pragma unroll
      for (int i = 0; i < 4; ++i) {
        if (isu) { f32x4 g = ((const f32x4*)p.g_ffn)[lane * 4 + i]; v[i] *= g; }
      }
      float mx = 0.f;
#pragma unroll
      for (int i = 0; i < 4; ++i) mx = fmaxf(mx, fmaxf(fmaxf(fabsf(v[i].x), fabsf(v[i].y)), fmaxf(fabsf(v[i].z), fabsf(v[i].w))));
#pragma unroll
      for (int o = 32; o > 0; o >>= 1) mx = fmaxf(mx, __shfl_xor(mx, o));
      mx = fmaxf(mx, 1e-30f);
      const float inv = 127.f / mx;
      unsigned w[4];
#pragma unroll
      for (int i = 0; i < 4; ++i) {
        const float ofs = isu ? 0.f : 128.f;
        unsigned b0 = (unsigned)(int)(rintf(v[i].x * inv) + ofs) & 0xffu, b1 = (unsigned)(int)(rintf(v[i].y * inv) + ofs) & 0xffu;
        unsigned b2 = (unsigned)(int)(rintf(v[i].z * inv) + ofs) & 0xffu, b3 = (unsigned)(int)(rintf(v[i].w * inv) + ofs) & 0xffu;
        w[i] = b0 | (b1 << 8) | (b2 << 16) | (b3 << 24);
      }
      u32x4* dst = (u32x4*)(p.ws + OFF_ub) + (size_t)e * 128 + (isu ? 0 : 64) + lane;
      *dst = mk4(w[0], w[1], w[2], w[3]);
      if (lane == 0) ((float*)(p.ws + (isu ? OFF_us : OFF_vs)))[e] = mx * (1.f / 127.f);
#pragma unroll
      for (int i = 0; i < 4; ++i) v[i] = vn[i];
    }
    const size_t gtid = (size_t)blockIdx.x * 256 + tid, gsz = (size_t)gridDim.x * 256;
    for (size_t i = gtid; i < 131072 / 4; i += gsz) {
      f32x4 a = ((const f32x4*)p.keys)[i];
      const int e0 = (int)i * 4;
      const int k = e0 & 63, n = (e0 >> 6) & 127, hp = e0 >> 13;
      const size_t off = ((size_t)((hp * 8 + (n >> 4)) * 2 + (k >> 5)) * 64 + ((k >> 3) & 3) * 16 + (n & 15)) * 8 + (k & 7);
      *(u32x2*)(WSP(u16, keysb) + off) = mk2(pk(a.x, a.y), pk(a.z, a.w));
    }
  }
  {
    float* wg = (float*)smem;
    {
      float tmp[32];
#pragma unroll
      for (int r = 0; r < 32; ++r) { int i = tid + 256 * r; int k = i >> 3, j = i & 7; tmp[r] = p.g1[k] * p.w_in[(size_t)k * 2824 + 2304 + j]; }
#pragma unroll
      for (int r = 0; r < 32; ++r) { int i = tid + 256 * r; int k = i >> 3, j = i & 7; wg[j * 1024 + k] = tmp[r]; }
    }
    __syncthreads();
    const int gw = blockIdx.x * 4 + wv, nw = gridDim.x * 4;
    f32x4 v[4], vn[4];
    if (gw < T) {
#pragma unroll
      for (int i = 0; i < 4; ++i) v[i] = ((const f32x4*)(p.x + (size_t)gw * 1024))[lane + 64 * i];
    }
    for (int row = gw; row < T; row += nw) {
      {
        const int rn = min(row + nw, T - 1);
#pragma unroll
        for (int i = 0; i < 4; ++i) vn[i] = ((const f32x4*)(p.x + (size_t)rn * 1024))[lane + 64 * i];
      }
      float ss = 0.f; float ga[8];
#pragma unroll
      for (int j = 0; j < 8; ++j) ga[j] = 0.f;
#pragma unroll
      for (int i = 0; i < 4; ++i) {
        ss += v[i].x * v[i].x + v[i].y * v[i].y + v[i].z * v[i].z + v[i].w * v[i].w;
#pragma unroll
        for (int j = 0; j < 8; ++j) {
          f32x4 w = ((const f32x4*)(wg + j * 1024))[lane + 64 * i];
          ga[j] += v[i].x * w.x + v[i].y * w.y + v[i].z * w.z + v[i].w * w.w;
        }
      }
      ss = wsum(ss);
      float mine;
      {
        const bool b0 = lane & 1, b1 = lane & 2, b2 = lane & 4;
        float k1[4], q1[2];
#pragma unroll
        for (int m = 0; m < 4; ++m) { float kp = b0 ? ga[2 * m + 1] : ga[2 * m], sd = b0 ? ga[2 * m] : ga[2 * m + 1]; k1[m] = kp + __shfl_xor(sd, 1); }
#pragma unroll
        for (int m = 0; m < 2; ++m) { float kp = b1 ? k1[2 * m + 1] : k1[2 * m], sd = b1 ? k1[2 * m] : k1[2 * m + 1]; q1[m] = kp + __shfl_xor(sd, 2); }
        mine = (b2 ? q1[1] : q1[0]) + __shfl_xor(b2 ? q1[0] : q1[1], 4);
        mine += __shfl_xor(mine, 8); mine += __shfl_xor(mine, 16); mine += __shfl_xor(mine, 32);
      }
      const float rstd = rsqrtf(ss * (1.f / 1024.f) + EPS);
      u32x2* xo = (u32x2*)(WSP(u16, mixA) + (size_t)row * 1024);
#pragma unroll
      for (int i = 0; i < 4; ++i) xo[lane + 64 * i] = mk2(pk(v[i].x, v[i].y), pk(v[i].z, v[i].w));
      if (lane == 0) WSP(float, rstd1)[row] = rstd;
      if (lane < 8) {
        float a = mine * rstd; int hh = lane & 3;
        if (lane < 4) {
          float xx = a + p.dt_bias[hh];
          float sp = (xx > 20.f) ? xx : log1pf(expf(xx));
          WSP(float, gate_g)[(size_t)row * 4 + hh] = -expf(p.a_log[hh]) * sp;
        } else {
          WSP(float, gate_b)[(size_t)row * 4 + hh] = 1.f / (1.f + expf(-a));
        }
      }
#pragma unroll
      for (int i = 0; i < 4; ++i) v[i] = vn[i];
    }
  }
}

template <class Pre, class Epi>
DI void gemm_tile(const u16* __restrict__ A, const u16* __restrict__ Bt, char* smem, Pre&& pre, Epi&& epi) {
  u16* As = (u16*)smem;
  const int tid = opaque_tid(), lane = tid & 63, wv = tid >> 6, l15 = lane & 15, quad = lane >> 4;
  f32x4 acc[4][8];
#pragma unroll
  for (int i = 0; i < 4; ++i)
#pragma unroll
    for (int j = 0; j < 8; ++j) acc[i][j] = fzero();
  u32x4 pa[4];
  bf16x8 w0[2][4], w1[2][4];
  const int lr = tid >> 3, lc = tid & 7;
  const u16* Ag = A + (size_t)lr * 1024 + lc * 8;
  const u16* Wg = Bt + ((size_t)(wv * 4) * 32 * 64 + lane) * 8;
#define GEMM_WLOAD(W, KT)                                                                          \
  {                                                                                               \
    _Pragma("unroll") for (int kk = 0; kk < 2; ++kk)                                              \
      _Pragma("unroll") for (int ft = 0; ft < 4; ++ft) W[kk][ft] = *(const bf16x8*)(Wg + (size_t)((ft * 32 + (KT) * 2 + kk) * 64) * 8); \
  }
#define GEMM_ALOAD(KT)                                                                             \
  { _Pragma("unroll") for (int i = 0; i < 4; ++i) pa[i] = *(const u32x4*)(Ag + (size_t)i * 32 * 1024 + (KT) * 64); }
#define GEMM_STEP(WC, WN, KT)                                                                      \
  {                                                                                               \
    __syncthreads();                                                                              \
    _Pragma("unroll") for (int i = 0; i < 4; ++i) *(u32x4*)(As + (lr + 32 * i) * 64 + ((lc ^ (lr & 7)) * 8)) = pa[i]; \
    __syncthreads();                                                                              \
    GEMM_ALOAD(min((KT) + 1, 15))                                                                 \
    GEMM_WLOAD(WN, min((KT) + 1, 15))                                                             \
    _Pragma("unroll") for (int kk = 0; kk < 2; ++kk) {                                            \
      _Pragma("unroll") for (int th = 0; th < 2; ++th) {                                          \
        bf16x8 af[4];                                                                             \
        _Pragma("unroll") for (int tt = 0; tt < 4; ++tt) af[tt] = *(const bf16x8*)(As + ((th * 4 + tt) * 16 + l15) * 64 + (((kk * 4 + quad) ^ (l15 & 7)) * 8)); \
        _Pragma("unroll") for (int ft = 0; ft < 4; ++ft)                                          \
          _Pragma("unroll") for (int tt = 0; tt < 4; ++tt) acc[ft][th * 4 + tt] = mfma16(WC[kk][ft], af[tt], acc[ft][th * 4 + tt]); \
        if (th == 1) __builtin_amdgcn_sched_barrier(0);     \
      }                                                                                           \
    }                                                                                             \
  }
  GEMM_ALOAD(0)
  GEMM_WLOAD(w0, 0)
  for (int kt = 0; kt < 16; kt += 2) {
    GEMM_STEP(w0, w1, kt)
    GEMM_STEP(w1, w0, kt + 1)
  }
#undef GEMM_WLOAD
#undef GEMM_ALOAD
#undef GEMM_STEP
  const int et = opaque_tid();
  const int el = et & 63, ewv = et >> 6, el15 = el & 15, equad = el >> 4;
#pragma unroll
  for (int th = 0; th < 2; ++th) {
    f32x4 pv[4][4];
#pragma unroll
    for (int ft = 0; ft < 4; ++ft)
#pragma unroll
      for (int tt = 0; tt < 4; ++tt) pv[ft][tt] = pre(th * 4 + tt, ft, ewv, el15, equad);
#pragma unroll
    for (int ft = 0; ft < 4; ++ft)
#pragma unroll
      for (int tt = 0; tt < 4; ++tt) epi(th * 4 + tt, ft, acc[ft][th * 4 + tt], pv[ft][tt], ewv, el15, equad);
    __builtin_amdgcn_sched_barrier(0);
  }
}

DI void phase1(const Params& p, char* smem) {
  const int tid_ = opaque_tid(); const int lane = tid_ & 63, wv = tid_ >> 6, l15 = lane & 15, quad = lane >> 4;
  const bool xcd_order = (gridDim.x & 7) == 0;
  const int xcd = blockIdx.x & 7, jb = blockIdx.x >> 3, nxb = gridDim.x >> 3;
  for (int it = xcd_order ? jb : (int)blockIdx.x; it < (xcd_order ? 704 : 5632); it += (xcd_order ? nxb : (int)gridDim.x)) {
    int mt, nt;
    if (xcd_order) {
      if (it < 640) { int np = it >> 7, r = it & 127; mt = xcd * 64 + (r >> 1); nt = 2 * np + (r & 1); }
      else { mt = xcd * 64 + (it - 640); nt = 10; }
    } else { mt = it / 11; nt = it % 11; }
    gemm_tile(WSP(u16, mixA) + (size_t)mt * 128 * 1024, WSP(u16, WinT) + (size_t)nt * 256 * 1024, smem,
      [&](int tt, int ft, int wv, int l15, int quad) { return mkf4(WSP(float, rstd1)[(size_t)mt * 128 + tt * 16 + l15], 0.f, 0.f, 0.f); },
      [&](int tt, int ft, f32x4 v, f32x4 pvv, int wv, int l15, int quad) {
      size_t t = (size_t)mt * 128 + tt * 16 + l15; int n = nt * 256 + wv * 64 + ft * 16 + quad * 4;
      float r = pvv[0];
      v[0] *= r; v[1] *= r; v[2] *= r; v[3] *= r;
      *(u32x2*)(WSP(u16, proj) + t * NP + n) = pack4(v);
    });
  }
}

DI void attn_item(const Params& p, int item, char* smem) {
  const int b = item >> 5, nb = item & 31;
  u16* Ks = (u16*)smem;
  u16* Vt = Ks + 256 * 72;
  const int tid = opaque_tid(), lane = tid & 63, wv = tid >> 6, l15 = lane & 15, quad = lane >> 4;
  const size_t tq0 = (size_t)b * 4096 + (size_t)nb * 128;
  float ssq0 = 0.f, ssq1 = 0.f;
  u32x4 qr0, qr1, qn0, qn1;
  {
    const u16* row = WSP(u16, proj) + (tq0 + wv * 32 + l15) * NP;
    qr0 = *(const u32x4*)(row + quad * 8); qr1 = *(const u32x4*)(row + 32 + quad * 8);
  }
#pragma unroll 1
  for (int it = 0; it < 16; ++it) {
    const int h = it >> 1, qt = it & 1, kvh = h >> 2;
    if ((it & 7) == 0) {
      __syncthreads();
      u32x4 kr[8], vr[8];
#pragma unroll
      for (int i = 0; i < 8; ++i) {
        int ch = tid + 256 * i; int kj = ch >> 3, c = ch & 7;
        int pos = max(nb * 128 - 128 + kj, 0);
        const u16* row = WSP(u16, proj) + ((size_t)b * 4096 + pos) * NP;
        kr[i] = *(const u32x4*)(row + 512 + kvh * 64 + c * 8);
        vr[i] = *(const u32x4*)(row + 640 + kvh * 64 + c * 8);
      }
#pragma unroll
      for (int i = 0; i < 8; ++i) {
        int ch = tid + 256 * i; int kj = ch >> 3, c = ch & 7;
        const bool valid = (nb * 128 - 128 + kj) >= 0;
        float kf[8]; unpack8(kr[i], kf);
        float s = 0.f;
#pragma unroll
        for (int e = 0; e < 8; ++e) s += kf[e] * kf[e];
        s += __shfl_xor(s, 1); s += __shfl_xor(s, 2); s += __shfl_xor(s, 4);
        float r = valid ? rsqrtf(s * (1.f / 64.f) + EPS) : 0.f;
#pragma unroll
        for (int e = 0; e < 8; ++e) kf[e] = kf[e] * r * p.gk[c * 8 + e];
        *(u32x4*)(Ks + kj * 72 + c * 8) = pack8(kf);
#pragma unroll
        for (int e = 0; e < 4; ++e) {
          unsigned wd = valid ? vr[i][e] : 0u;
          Vt[(c * 8 + 2 * e) * 264 + kj] = (u16)(wd & 0xffffu); Vt[(c * 8 + 2 * e + 1) * 264 + kj] = (u16)(wd >> 16);
        }
      }
      __syncthreads();
    }
    {
      const int itn = min(it + 1, 15);
      const u16* row = WSP(u16, proj) + (tq0 + wv * 32 + (itn & 1) * 16 + l15) * NP + (itn >> 1) * 64;
      qn0 = *(const u32x4*)(row + quad * 8); qn1 = *(const u32x4*)(row + 32 + quad * 8);
    }
    {
      const float sink = p.sinks[h];
      const int qi = wv * 32 + qt * 16 + l15;
      bf16x8 qf0, qf1;
      {
        float f0[8], f1[8]; unpack8(qr0, f0); unpack8(qr1, f1);
        float s = 0.f;
#pragma unroll
        for (int e = 0; e < 8; ++e) s += f0[e] * f0[e] + f1[e] * f1[e];
        s += __shfl_xor(s, 16); s += __shfl_xor(s, 32);
        float r = rsqrtf(s * (1.f / 64.f) + EPS) * 0.125f;
#pragma unroll
        for (int e = 0; e < 8; ++e) { f0[e] *= r * p.gq[quad * 8 + e]; f1[e] *= r * p.gq[32 + quad * 8 + e]; }
        qf0 = as_frag(pack8(f0)); qf1 = as_frag(pack8(f1));
      }
      f32x4 S[10];
#pragma unroll
      for (int i = 0; i < 10; ++i) {
        int kj0 = (2 * wv + i) * 16;
        bf16x8 k0 = *(const bf16x8*)(Ks + (kj0 + l15) * 72 + quad * 8);
        bf16x8 k1 = *(const bf16x8*)(Ks + (kj0 + l15) * 72 + 32 + quad * 8);
        f32x4 a = fzero();
        a = mfma16(k0, qf0, a);
        a = mfma16(k1, qf1, a);
        S[i] = a;
        if (i & 1) __builtin_amdgcn_sched_barrier(0);
      }
      float mx = -INFINITY;
#pragma unroll
      for (int i = 0; i < 10; ++i) {
        const bool interior = (i >= qt + 1) && (i <= qt + 7) && (nb > 0);
        if (interior) {
#pragma unroll
          for (int r = 0; r < 4; ++r) mx = fmaxf(mx, S[i][r]);
        } else {
#pragma unroll
          for (int r = 0; r < 4; ++r) {
            int kj = (2 * wv + i) * 16 + quad * 4 + r;
            int rel = qi + 128 - kj;
            bool ok = (rel >= 0) && (rel < 128) && (nb > 0 || kj >= 128);
            float s = ok ? S[i][r] : -INFINITY;
            S[i][r] = s; mx = fmaxf(mx, s);
          }
        }
      }
      mx = fmaxf(mx, __shfl_xor(mx, 16)); mx = fmaxf(mx, __shfl_xor(mx, 32));
      const float m = fmaxf(mx, sink);
      float sum = 0.f;
#pragma unroll
      for (int i = 0; i < 10; ++i)
#pragma unroll
        for (int r = 0; r < 4; ++r) { float pv = __expf(S[i][r] - m); S[i][r] = pv; sum += pv; }
      sum += __shfl_xor(sum, 16); sum += __shfl_xor(sum, 32);
      const float inv = 1.f / (sum + __expf(sink - m));
      f32x4 O[4];
#pragma unroll
      for (int dt = 0; dt < 4; ++dt) O[dt] = fzero();
#pragma unroll
      for (int ip = 0; ip < 5; ++ip) {
        const int kja = (2 * wv + 2 * ip) * 16 + quad * 4, kjb = kja + 16;
        f32x4 a = S[2 * ip], c = S[2 * ip + 1];
        bf16x8 pf = as_frag(mk4(pk(a[0], a[1]), pk(a[2], a[3]), pk(c[0], c[1]), pk(c[2], c[3])));
#pragma unroll
        for (int dt = 0; dt < 4; ++dt) {
          int d = dt * 16 + l15;
          u32x2 va = *(const u32x2*)(Vt + d * 264 + kja), vb2 = *(const u32x2*)(Vt + d * 264 + kjb);
          bf16x8 vf = as_frag(mk4(va.x, va.y, vb2.x, vb2.y));
          O[dt] = mfma16(vf, pf, O[dt]);
        }
        __builtin_amdgcn_sched_barrier(0);
      }
      float sq = 0.f;
      const size_t t = tq0 + qi;
#pragma unroll
      for (int dt = 0; dt < 4; ++dt) {
        f32x4 o = O[dt];
        o[0] *= inv; o[1] *= inv; o[2] *= inv; o[3] *= inv;
        sq += o[0] * o[0] + o[1] * o[1] + o[2] * o[2] + o[3] * o[3];
        *(u32x2*)(WSP(u16, mixA) + t * 1024 + h * 64 + dt * 16 + quad * 4) = pack4(o);
      }
      ssq0 += (qt == 0) ? sq : 0.f; ssq1 += (qt == 0) ? 0.f : sq;
    }
    qr0 = qn0; qr1 = qn1;
  }
  {
    float s = ssq0;
    s += __shfl_xor(s, 16); s += __shfl_xor(s, 32);
    const float r0 = rsqrtf(s * (1.f / 512.f) + EPS);
    s = ssq1;
    s += __shfl_xor(s, 16); s += __shfl_xor(s, 32);
    const float r1 = rsqrtf(s * (1.f / 512.f) + EPS);
#pragma unroll 1
    for (int hb2 = 0; hb2 < 2; ++hb2) {
      u32x2 pc[32];
#pragma unroll
      for (int j = 0; j < 32; ++j) {
        const int h = hb2 * 4 + (j >> 3), qt = (j >> 2) & 1, dt = j & 3;
        pc[j] = *(const u32x2*)(WSP(u16, mixA) + (tq0 + wv * 32 + qt * 16 + l15) * 1024 + h * 64 + dt * 16 + quad * 4);
      }
#pragma unroll
      for (int j = 0; j < 32; ++j) {
        const int h = hb2 * 4 + (j >> 3), qt = (j >> 2) & 1, dt = j & 3;
        const float r = qt ? r1 : r0;
        f32x4 o = mkf4(bflo(pc[j].x) * r, bfhi(pc[j].x) * r, bflo(pc[j].y) * r, bfhi(pc[j].y) * r);
        *(u32x2*)(WSP(u16, mixA) + (tq0 + wv * 32 + qt * 16 + l15) * 1024 + h * 64 + dt * 16 + quad * 4) = pack4(o);
      }
    }
  }
}

DI void dn_conv_load(const Params& p, int type, int h, int c, size_t t0, int tid, u32x4* raw) {
  const int rg = tid >> 4, cg = tid & 15;
  const u16* base = WSP(u16, proj) + 768 + type * 512 + h * 128 + cg * 8;
#pragma unroll
  for (int j = 0; j < 7; ++j) {
    int row = 4 * rg - 3 + j;
    int srow = c * 64 + row;
    size_t t = (srow >= 0) ? (size_t)((long)t0 + row) : t0;
    raw[j] = *(const u32x4*)(base + t * NP);
  }
}
DI void dn_conv_compute(const Params& p, int type, int h, int c, int tid, const u32x4* raw, float* F) {
  const int rg = tid >> 4, cg = tid & 15;
  const int ch = type * 512 + h * 128 + cg * 8;
  float w[4][8];
#pragma unroll
  for (int j = 0; j < 4; ++j) {
    f32x4 a = *(const f32x4*)(p.convw + j * 1536 + ch), b = *(const f32x4*)(p.convw + j * 1536 + ch + 4);
    w[j][0] = a.x; w[j][1] = a.y; w[j][2] = a.z; w[j][3] = a.w; w[j][4] = b.x; w[j][5] = b.y; w[j][6] = b.z; w[j][7] = b.w;
  }
  float x[7][8];
#pragma unroll
  for (int j = 0; j < 7; ++j) {
    unpack8(raw[j], x[j]);
    if (c * 64 + 4 * rg - 3 + j < 0) {
#pragma unroll
      for (int e = 0; e < 8; ++e) x[j][e] = 0.f;
    }
  }
#pragma unroll
  for (int r = 0; r < 4; ++r) {
    float y[8];
#pragma unroll
    for (int e = 0; e < 8; ++e) {
      float v = w[0][e] * x[r][e] + w[1][e] * x[r + 1][e] + w[2][e] * x[r + 2][e] + w[3][e] * x[r + 3][e];
      y[e] = v / (1.f + __expf(-v));
    }
    float* dst = F + (4 * rg + r) * 128 + cg * 8;
    *(f32x4*)dst = mkf4(y[0], y[1], y[2], y[3]);
    *(f32x4*)(dst + 4) = mkf4(y[4], y[5], y[6], y[7]);
  }
}
DI void dn_rownorm(const float* F, float* rn) {
  const int tid = opaque_tid();
  const int cc = tid >> 2, part = tid & 3;
  float s = 0.f;
#pragma unroll 8
  for (int i = 0; i < 32; ++i) { float v = F[cc * 128 + part * 32 + ((i + tid) & 31)]; s += v * v; }
  s += __shfl_xor(s, 1); s += __shfl_xor(s, 2);
  if (part == 0) rn[cc] = rsqrtf(s + EPS);
}

DI void dn_chunk_item(const Params& p, int ci, char* smem) {
  const int c = ci & 63, h = (ci >> 6) & 3, b = ci >> 8;
  float* F = (float*)smem;
  u16* kbf = (u16*)(smem + 32768);
  u16* qbf = kbf + 64 * 136;
  float* gcs = (float*)(smem + 32768 + 2 * 17408);
  float* bet = gcs + 64; float* rn = gcs + 128;
  const int tid = opaque_tid(), lane = tid & 63, wv = tid >> 6, l15 = lane & 15, quad = lane >> 4;
  const size_t t0 = (size_t)b * 4096 + (size_t)c * 64;
  float sol[64];
  u32x4 rawk[7], rawq[7], rawv[7];
  dn_conv_load(p, 1, h, c, t0, tid, rawk);
  dn_conv_load(p, 0, h, c, t0, tid, rawq);
  dn_conv_load(p, 2, h, c, t0, tid, rawv);
  __syncthreads();
  if (tid < 64) {
    float g = WSP(float, gate_g)[(t0 + tid) * 4 + h];
#pragma unroll
    for (int o = 1; o < 64; o <<= 1) { float n = __shfl_up(g, o); if (lane >= o) g += n; }
    gcs[tid] = g; bet[tid] = WSP(float, gate_b)[(t0 + tid) * 4 + h]; gcs[192 + tid] = __expf(g);
  }
  dn_conv_compute(p, 1, h, c, tid, rawk, F);
  __syncthreads();
  dn_rownorm(F, rn);
  __syncthreads();
  {
    const int d = tid & 127, half = tid >> 7;
#pragma unroll 8
    for (int i = 0; i < 32; ++i) { int cc = half * 32 + i; kbf[cc * 136 + d] = f2bf(F[cc * 128 + d] * rn[cc]); }
    if (tid >= 128) {
#pragma unroll
      for (int cc = 0; cc < 64; ++cc) sol[cc] = F[cc * 128 + d] * rn[cc] * bet[cc] * gcs[192 + cc];
    }
  }
  __syncthreads();
  dn_conv_compute(p, 0, h, c, tid, rawq, F);
  __syncthreads();
  dn_rownorm(F, rn);
  __syncthreads();
  {
    const int d = tid & 127, half = tid >> 7;
#pragma unroll 8
    for (int i = 0; i < 32; ++i) { int cc = half * 32 + i; qbf[cc * 136 + d] = f2bf(F[cc * 128 + d] * rn[cc] * 0.08838834764831845f); }
  }
  __syncthreads();
  dn_conv_compute(p, 2, h, c, tid, rawv, F);
  __syncthreads();
  if (tid < 128) {
#pragma unroll
    for (int cc = 0; cc < 64; ++cc) sol[cc] = F[cc * 128 + tid] * bet[cc];
  }
  __syncthreads();
  float* Mf = F;
  {
    bf16x8 kc[4], qc[4];
#pragma unroll
    for (int kk = 0; kk < 4; ++kk) {
      kc[kk] = *(const bf16x8*)(kbf + (wv * 16 + l15) * 136 + kk * 32 + quad * 8);
      qc[kk] = *(const bf16x8*)(qbf + (wv * 16 + l15) * 136 + kk * 32 + quad * 8);
    }
    const int ci_ = wv * 16 + l15;
    const float gci = gcs[ci_], bi = bet[ci_];
#pragma unroll
    for (int jt = 0; jt < 4; ++jt) {
      f32x4 akk = fzero(), aqk = fzero();
#pragma unroll
      for (int kk = 0; kk < 4; ++kk) {
        bf16x8 kj = *(const bf16x8*)(kbf + (jt * 16 + l15) * 136 + kk * 32 + quad * 8);
        akk = mfma16(kj, kc[kk], akk);
        aqk = mfma16(kj, qc[kk], aqk);
      }
      f32x4 m4, q4;
#pragma unroll
      for (int r = 0; r < 4; ++r) {
        int j = jt * 16 + quad * 4 + r;
        float dec = __expf(fminf(gci - gcs[j], 0.f));
        m4[r] = (ci_ > j) ? bi * akk[r] * dec : 0.f;
        q4[r] = (ci_ >= j) ? aqk[r] * dec : 0.f;
      }
      *(f32x4*)(Mf + ci_ * 64 + jt * 16 + quad * 4) = mkf4(m4[0], m4[1], m4[2], m4[3]);
      *(u32x2*)(WSP(u16, qk) + ((size_t)ci * 64 + ci_) * 64 + jt * 16 + quad * 4) = pack4(q4);
    }
  }
  __syncthreads();
  {
    const int d = tid & 127, half = tid >> 7;
#pragma unroll 8
    for (int i = 0; i < 32; ++i) {
      int cc = half * 32 + i;
      WSP(u16, qd)[(size_t)ci * 8192 + cc * 128 + d] = f2bf(bf2f(qbf[cc * 136 + d]) * gcs[192 + cc]);
    }
    const int c2 = tid & 63, dg = tid >> 6;
    const float e = __expf(gcs[63] - gcs[c2]);
#pragma unroll 8
    for (int i = 0; i < 32; ++i) {
      int dd = dg * 32 + i;
      WSP(u16, kdT)[(size_t)ci * 8192 + dd * 64 + c2] = f2bf(bf2f(kbf[c2 * 136 + dd]) * e);
    }
    if (tid == 0) WSP(float, cd)[ci] = __expf(gcs[63]);
  }
  __syncthreads();
  {
    u16* Xt = (u16*)(smem + 32768);
    float* Cs = F + 4096;
    const int col = tid;
    {
      u32x4* z = (u32x4*)(Xt + col * 72);
#pragma unroll
      for (int i = 0; i < 9; ++i) z[i] = mk4(0u, 0u, 0u, 0u);
    }
#pragma unroll
    for (int bi = 0; bi < 4; ++bi) {
      float c16[16];
#pragma unroll
      for (int r = 0; r < 16; ++r) c16[r] = 0.f;
      if (bi > 0) {
        const int nks = (bi == 3) ? 2 : 1;
        bf16x8 af[2];
#pragma unroll
        for (int ks = 0; ks < 2; ++ks) {
          if (ks < nks) {
            const float* mp = Mf + (16 * bi + l15) * 64 + ks * 32 + quad * 8;
            f32x4 m0 = *(const f32x4*)mp, m1 = *(const f32x4*)(mp + 4);
            const bool keep = (ks * 32 + quad * 8) < 16 * bi;
            if (!keep) { m0 = fzero(); m1 = fzero(); }
            af[ks] = as_frag(mk4(pk(m0[0], m0[1]), pk(m0[2], m0[3]), pk(m1[0], m1[1]), pk(m1[2], m1[3])));
          }
        }
#pragma unroll
        for (int ct = 0; ct < 4; ++ct) {
          const int cb = (wv * 4 + ct) * 16 + l15;
          f32x4 a = fzero();
#pragma unroll
          for (int ks = 0; ks < 2; ++ks) {
            if (ks < nks) {
              bf16x8 xb = *(const bf16x8*)(Xt + cb * 72 + ks * 32 + quad * 8);
              a = mfma16(af[ks], xb, a);
            }
          }
          *(f32x4*)(Cs + cb * 16 + quad * 4) = a;
        }
        asm volatile("s_waitcnt lgkmcnt(0)" ::: "memory");
#pragma unroll
        for (int q = 0; q < 4; ++q) {
          f32x4 cv = *(const f32x4*)(Cs + col * 16 + q * 4);
          c16[4 * q] = cv[0]; c16[4 * q + 1] = cv[1]; c16[4 * q + 2] = cv[2]; c16[4 * q + 3] = cv[3];
        }
      }
#pragma unroll
      for (int r = 0; r < 16; ++r) {
        const int cc = 16 * bi + r;
        float a = sol[cc] - c16[r];
#pragma unroll
        for (int j4 = 4 * bi; j4 < (cc + 3) / 4; ++j4) {
          f32x4 m = *(const f32x4*)(Mf + cc * 64 + j4 * 4);
          a -= m.x * sol[j4 * 4] + m.y * sol[j4 * 4 + 1] + m.z * sol[j4 * 4 + 2] + m.w * sol[j4 * 4 + 3];
        }
        sol[cc] = a;
      }
      if (bi < 3) {
        u32x4* xo = (u32x4*)(Xt + col * 72 + 16 * bi);
        xo[0] = mk4(pk(sol[16 * bi], sol[16 * bi + 1]), pk(sol[16 * bi + 2], sol[16 * bi + 3]), pk(sol[16 * bi + 4], sol[16 * bi + 5]),
                    pk(sol[16 * bi + 6], sol[16 * bi + 7]));
        xo[1] = mk4(pk(sol[16 * bi + 8], sol[16 * bi + 9]), pk(sol[16 * bi + 10], sol[16 * bi + 11]), pk(sol[16 * bi + 12], sol[16 * bi + 13]),
                    pk(sol[16 * bi + 14], sol[16 * bi + 15]));
        asm volatile("s_waitcnt lgkmcnt(0)" ::: "memory");
      }
    }
  }
  {
    u16* dst = (u16*)(p.ws + ((tid < 128) ? OFF_u_ : OFF_w_)) + (size_t)ci * 8192 + (tid & 127);
#pragma unroll
    for (int cc = 0; cc < 64; ++cc) dst[cc * 128] = f2bf(sol[cc]);
  }
}

struct ScanFrag { bf16x8 wf[4], qf[4], qkf[2], kf[2][2]; u32x2 uu; float cdv; };

DI void scan_load(const Params& p, int bh, int s, int sl, ScanFrag& f) {
  const int tid_ = opaque_tid(); const int lane = tid_ & 63, wv = tid_ >> 6, l15 = lane & 15, quad = lane >> 4;
  const size_t ci = (size_t)bh * 64 + s;
  const u16* wb = WSP(u16, w_) + ci * 8192 + (wv * 16 + l15) * 128 + quad * 8;
  const u16* qb = WSP(u16, qd) + ci * 8192 + (wv * 16 + l15) * 128 + quad * 8;
#pragma unroll
  for (int kk = 0; kk < 4; ++kk) { f.wf[kk] = *(const bf16x8*)(wb + kk * 32); f.qf[kk] = *(const bf16x8*)(qb + kk * 32); }
  const u16* qkb = WSP(u16, qk) + ci * 4096 + (wv * 16 + l15) * 64 + quad * 8;
#pragma unroll
  for (int k2 = 0; k2 < 2; ++k2) f.qkf[k2] = *(const bf16x8*)(qkb + k2 * 32);
#pragma unroll
  for (int dt = 0; dt < 2; ++dt)
#pragma unroll
    for (int k2 = 0; k2 < 2; ++k2)
      f.kf[dt][k2] = *(const bf16x8*)(WSP(u16, kdT) + ci * 8192 + ((2 * wv + dt) * 16 + l15) * 64 + k2 * 32 + quad * 8);
  f.uu = *(const u32x2*)(WSP(u16, u_) + ci * 8192 + (wv * 16 + l15) * 128 + sl * 16 + quad * 4);
  f.cdv = WSP(float, cd)[ci];
}

DI void dn_scan_item(const Params& p, int item, char* smem) {
  const int bh = (item & 7) + 8 * (item >> 6), sl = (item >> 3) & 7;
  const int b = bh >> 2, h = bh & 3;
  u16* St = (u16*)smem;
  u16* vnT = St + 16 * 136;
  const int tid = opaque_tid(), lane = tid & 63, wv = tid >> 6, l15 = lane & 15, quad = lane >> 4;
  __syncthreads();
  for (int i = tid; i < 16 * 136; i += 256) St[i] = 0;
  f32x4 Sacc[2] = {fzero(), fzero()};
  ScanFrag fa, fb, fc;
  scan_load(p, bh, 0, sl, fa);
  scan_load(p, bh, 1, sl, fb);
  __syncthreads();
  auto step = [&](const ScanFrag& cur, int s) {
    bf16x8 sa[4];
#pragma unroll
    for (int kk = 0; kk < 4; ++kk) sa[kk] = *(const bf16x8*)(St + l15 * 136 + kk * 32 + quad * 8);
    f32x4 av = fzero(), ao = fzero();
#pragma unroll
    for (int kk = 0; kk < 4; ++kk) { av = mfma16(sa[kk], cur.wf[kk], av); ao = mfma16(sa[kk], cur.qf[kk], ao); }
    float vn[4];
    vn[0] = bflo(cur.uu.x) - av[0]; vn[1] = bfhi(cur.uu.x) - av[1];
    vn[2] = bflo(cur.uu.y) - av[2]; vn[3] = bfhi(cur.uu.y) - av[3];
#pragma unroll
    for (int r = 0; r < 4; ++r) vnT[(quad * 4 + r) * 72 + wv * 16 + l15] = f2bf(vn[r]);
    lds_barrier();
    bf16x8 va[2];
#pragma unroll
    for (int k2 = 0; k2 < 2; ++k2) va[k2] = *(const bf16x8*)(vnT + l15 * 72 + k2 * 32 + quad * 8);
#pragma unroll
    for (int k2 = 0; k2 < 2; ++k2) ao = mfma16(va[k2], cur.qkf[k2], ao);
    {
      size_t t = (size_t)b * 4096 + (size_t)s * 64 + wv * 16 + l15;
      *(u32x2*)(WSP(u16, mixA) + t * 1024 + 512 + h * 128 + sl * 16 + quad * 4) = pack4(ao);
    }
#pragma unroll
    for (int dt = 0; dt < 2; ++dt) {
      f32x4 sv = Sacc[dt];
      sv[0] *= cur.cdv; sv[1] *= cur.cdv; sv[2] *= cur.cdv; sv[3] *= cur.cdv;
#pragma unroll
      for (int k2 = 0; k2 < 2; ++k2) sv = mfma16(va[k2], cur.kf[dt][k2], sv);
      Sacc[dt] = sv;
#pragma unroll
      for (int r = 0; r < 4; ++r) St[(quad * 4 + r) * 136 + (2 * wv + dt) * 16 + l15] = f2bf(sv[r]);
    }
    lds_barrier();
  };
  for (int s = 0; s < 63; s += 3) {
    scan_load(p, bh, s + 2, sl, fc);
    step(fa, s);
    scan_load(p, bh, min(s + 3, 63), sl, fa);
    step(fb, s + 1);
    scan_load(p, bh, min(s + 4, 63), sl, fb);
    step(fc, s + 2);
  }
  step(fa, 63);
}

DI unsigned enc_f(float f) { unsigned u = __float_as_uint(f); return (u & 0x80000000u) ? ~u : (u | 0x80000000u); }
DI float dec_f(unsigned k) { unsigned u = (k & 0x80000000u) ? (k ^ 0x80000000u) : ~k; return __uint_as_float(u); }

DI void p4_gemm2(const Params& p, int tile, char* smem) {
  const int tid = opaque_tid(), lane = tid & 63, wv = tid >> 6, l15 = lane & 15, quad = lane >> 4;
  const size_t t0 = (size_t)tile * 128;
  float* ssq_l = (float*)(smem + 74752);
  __syncthreads();
  if (tid < 128) ssq_l[tid] = 0.f;
  for (int i0 = 0; i0 < 32; i0 += 4) {
    const int cc = tid & 63;
    u32x4 rd[4], rz[4];
#pragma unroll
    for (int i = 0; i < 4; ++i) {
      size_t t = t0 + (tid >> 6) + 4 * (i0 + i);
      rd[i] = *(const u32x4*)(WSP(u16, mixA) + t * 1024 + 512 + cc * 8);
      rz[i] = *(const u32x4*)(WSP(u16, proj) + t * NP + 2304 + cc * 8);
    }
#pragma unroll
    for (int i = 0; i < 4; ++i) {
      size_t t = t0 + (tid >> 6) + 4 * (i0 + i);
      float f[8], z[8];
      unpack8(rd[i], f); unpack8(rz[i], z);
      float sq = 0.f;
#pragma unroll
      for (int e = 0; e < 8; ++e) sq += f[e] * f[e];
#pragma unroll
      for (int m = 1; m < 16; m <<= 1) sq += __int_as_float(__builtin_amdgcn_ds_bpermute((cc ^ m) << 2, __float_as_int(sq)));
      float r = rsqrtf(sq * (1.f / 128.f) + EPS);
#pragma unroll
      for (int e = 0; e < 8; ++e) f[e] = f[e] * r * p.g_o[(cc & 15) * 8 + e] * (z[e] / (1.f + __expf(-z[e])));
      *(u32x4*)(WSP(u16, mixA) + t * 1024 + 512 + cc * 8) = pack8(f);
    }
  }
  __syncthreads();
  {
    for (int nc = 0; nc < 4; ++nc) {
      float ssq[8] = {0.f, 0.f, 0.f, 0.f, 0.f, 0.f, 0.f, 0.f};
      gemm_tile(WSP(u16, mixA) + t0 * 1024, WSP(u16, WoutT) + (size_t)nc * 256 * 1024, smem,
        [&](int tt, int ft, int wv, int l15, int quad) {
        size_t t = t0 + tt * 16 + l15; int n = nc * 256 + wv * 64 + ft * 16 + quad * 4;
        return *(const f32x4*)(p.x + t * 1024 + n);
      },
        [&](int tt, int ft, f32x4 v, f32x4 xv, int wv, int l15, int quad) {
        size_t t = t0 + tt * 16 + l15; int n = nc * 256 + wv * 64 + ft * 16 + quad * 4;
        f32x4 hv = xv + v;
        *(u32x2*)(WSP(u16, hb) + t * 1024 + n) = pack4(hv);
        ssq[tt] += hv[0] * hv[0] + hv[1] * hv[1] + hv[2] * hv[2] + hv[3] * hv[3];
      });
      {
        const int t2 = opaque_tid(); const int ln = t2 & 63, l15b = ln & 15, qdb = ln >> 4;
#pragma unroll
        for (int tt = 0; tt < 8; ++tt) {
          float sv = ssq[tt];
          sv += __int_as_float(__builtin_amdgcn_ds_bpermute((ln ^ 16) << 2, __float_as_int(sv)));
          sv += __int_as_float(__builtin_amdgcn_ds_bpermute((ln ^ 32) << 2, __float_as_int(sv)));
          if (qdb == 0) atomicAdd(&ssq_l[tt * 16 + l15b], sv);
        }
      }
    }
  }
  __syncthreads();
  {
    const int t3 = opaque_tid();
    if (t3 < 128) WSP(float, rstd2)[t0 + t3] = rsqrtf(ssq_l[t3] * (1.f / 1024.f) + EPS);
  }
}

DI void p4_gemm3(const Params& p, int tile, char* smem) {
  const int tid = opaque_tid(), lane = tid & 63, wv = tid >> 6, l15 = lane & 15, quad = lane >> 4;
  const size_t t0 = (size_t)tile * 128;
  for (int nc = 0; nc < 4; ++nc) {
    gemm_tile(WSP(u16, hb) + t0 * 1024, WSP(u16, WqT) + (size_t)nc * 256 * 1024, smem,
      [&](int tt, int ft, int wv, int l15, int quad) { return mkf4(WSP(float, rstd2)[t0 + tt * 16 + l15], 0.f, 0.f, 0.f); },
      [&](int tt, int ft, f32x4 v, f32x4 pvv, int wv, int l15, int quad) {
      int tl = tt * 16 + l15; size_t t = t0 + tl; int n = nc * 256 + wv * 64 + ft * 16 + quad * 4;
      float r = pvv[0];
      v[0] *= r; v[1] *= r; v[2] *= r; v[3] *= r;
      *(u32x2*)(WSP(u16, qp) + t * 1024 + n) = pack4(v);
    });
  }
}

DI void bitonic_sort16_desc(unsigned* a) {
#pragma unroll
  for (int k = 2; k <= 16; k <<= 1)
#pragma unroll
    for (int j = k >> 1; j > 0; j >>= 1)
#pragma unroll
      for (int i = 0; i < 16; ++i) {
        const int l = i ^ j;
        if (l > i) {
          const bool desc = ((i & k) == 0);
          const unsigned hi = max(a[i], a[l]), lo = min(a[i], a[l]);
          a[i] = desc ? hi : lo; a[l] = desc ? lo : hi;
        }
      }
}
DI void merge_top16(unsigned* a, const unsigned* b) {
#pragma unroll
  for (int i = 0; i < 16; ++i) a[i] = max(a[i], b[15 - i]);
#pragma unroll
  for (int j = 8; j > 0; j >>= 1)
#pragma unroll
    for (int i = 0; i < 16; ++i) {
      const int l = i ^ j;
      if (l > i) { const unsigned hi = max(a[i], a[l]), lo = min(a[i], a[l]); a[i] = hi; a[l] = lo; }
    }
}

constexpr unsigned char PEER_CAND[52] = {0, 1, 2, 3, 4, 5, 6, 7, 8, 9, 10, 11, 12, 13, 14, 15, 16, 17, 18, 19, 20, 21, 22, 23, 32, 33, 34, 35, 36, 48, 49, 50, 51, 64, 65, 66, 80, 81, 96, 97, 112, 113, 128, 144, 160, 176, 192, 208, 224, 240, 255, 255};

DI void p4_peer(const Params& p, int tile, char* smem) {
  const int tid = opaque_tid(), lane = tid & 63, wv = tid >> 6, l15 = lane & 15, quad = lane >> 4;
  const size_t t0 = (size_t)tile * 64;
  float* scb = (float*)smem;
  unsigned* tk = (unsigned*)(smem + 66048);
  float* rstd2 = (float*)(smem + 74752);
  __syncthreads();
  if (tid < 64) rstd2[tid] = WSP(float, rstd2)[t0 + tid];
  for (int h = 0; h < 8; ++h) {
    __syncthreads();
#pragma unroll
    for (int pp = 0; pp < 2; ++pp) {
      const u16* qrow = WSP(u16, qp) + (t0 + wv * 16 + l15) * 1024 + h * 128 + pp * 64 + quad * 8;
      bf16x8 tf0 = *(const bf16x8*)qrow, tf1 = *(const bf16x8*)(qrow + 32);
      const int list = (wv * 16 + l15) * 2 + pp;
#pragma unroll
      for (int nt = 0; nt < 8; ++nt) {
        const u16* kfr = WSP(u16, keysb) + ((size_t)(((h * 2 + pp) * 8 + nt) * 2) * 64 + lane) * 8;
        bf16x8 k0 = *(const bf16x8*)kfr, k1 = *(const bf16x8*)(kfr + 512);
        f32x4 a = fzero();
        a = mfma16(k0, tf0, a); a = mfma16(k1, tf1, a);
#pragma unroll
        for (int r = 0; r < 4; ++r) scb[list * 129 + nt * 16 + quad * 4 + r] = a[r];
      }
    }
    __syncthreads();
    {
      const int list = tid >> 1, half = tid & 1;
      unsigned best[16];
#pragma unroll
      for (int g = 0; g < 4; ++g) {
        unsigned cur[16];
#pragma unroll
        for (int i = 0; i < 16; ++i) {
          const int n = half * 64 + g * 16 + i;
          cur[i] = (enc_f(scb[list * 129 + n]) & ~127u) | (unsigned)n;
        }
        bitonic_sort16_desc(cur);
        if (g == 0) {
#pragma unroll
          for (int i = 0; i < 16; ++i) best[i] = cur[i];
        } else merge_top16(best, cur);
      }
      unsigned oth[16];
#pragma unroll
      for (int i = 0; i < 16; ++i) oth[i] = (unsigned)__shfl_xor((int)best[i], 1);
      merge_top16(best, oth);
      if (half == 0) {
#pragma unroll
        for (int i = 0; i < 16; ++i) tk[list * 17 + i] = best[i];
      }
    }
    __syncthreads();
    {
      const int tok = tid >> 2, role = tid & 3;
      const unsigned* ta = tk + (tok * 2) * 17;
      const unsigned* tb = tk + (tok * 2 + 1) * 17;
      unsigned top[16];
#pragma unroll
      for (int m = 0; m < 13; ++m) {
        const unsigned c0 = PEER_CAND[4 * m], c1 = PEER_CAND[4 * m + 1], c2 = PEER_CAND[4 * m + 2], c3 = PEER_CAND[4 * m + 3];
        const unsigned code = (role == 0) ? c0 : (role == 1) ? c1 : (role == 2) ? c2 : c3;
        const bool ok = code != 255u;
        const unsigned cc = ok ? code : 0u;
        const float sa = dec_f(ta[cc >> 4] & ~127u), sb = dec_f(tb[cc & 15u] & ~127u);
        top[m] = ok ? ((enc_f(sa + sb) & ~255u) | cc) : 0u;
      }
      top[13] = 0u; top[14] = 0u; top[15] = 0u;
      bitonic_sort16_desc(top);
      unsigned oth[16];
#pragma unroll
      for (int i = 0; i < 16; ++i) oth[i] = (unsigned)__shfl_xor((int)top[i], 1);
      merge_top16(top, oth);
#pragma unroll
      for (int i = 0; i < 16; ++i) oth[i] = (unsigned)__shfl_xor((int)top[i], 2);
      merge_top16(top, oth);
      const float mx = dec_f(top[0] & ~255u);
      unsigned mine[4]; float ev[4]; float sum = 0.f;
#pragma unroll
      for (int mm = 0; mm < 4; ++mm) {
        mine[mm] = (role == 0) ? top[mm] : (role == 1) ? top[4 + mm] : (role == 2) ? top[8 + mm] : top[12 + mm];
        ev[mm] = __expf(dec_f(mine[mm] & ~255u) - mx); sum += ev[mm];
      }
      sum += __shfl_xor(sum, 1); sum += __shfl_xor(sum, 2);
      const float isum = 1.f / sum;
      const size_t t = t0 + tok;
#pragma unroll
      for (int mm = 0; mm < 4; ++mm) {
        const unsigned code = mine[mm] & 255u;
        const unsigned ia = ta[code >> 4] & 127u, ib = tb[code & 15u] & 127u;
        WSP(int, pidx)[t * 128 + h * 16 + role * 4 + mm] = (int)(ia * 128u + ib);
        WSP(float, pgate)[t * 128 + h * 16 + role * 4 + mm] = ev[mm] * isum;
      }
    }
  }
  __syncthreads();
  u32x4 nh0, nh1; int nid0, nid1; float ng0, ng1;
  {
    const size_t t = t0 + wv * 16;
    const u32x4* hrow = (const u32x4*)(WSP(u16, hb) + t * 1024);
    nh0 = hrow[lane * 2]; nh1 = hrow[lane * 2 + 1];
    nid0 = WSP(int, pidx)[t * 128 + lane]; nid1 = WSP(int, pidx)[t * 128 + 64 + lane];
    ng0 = WSP(float, pgate)[t * 128 + lane]; ng1 = WSP(float, pgate)[t * 128 + 64 + lane];
  }
  for (int tt = 0; tt < 16; ++tt) {
    const int tl = wv * 16 + tt; const size_t t = t0 + tl;
    const float rs = rstd2[tl];
    const u32x4 ch0 = nh0, ch1 = nh1;
    const int id0 = nid0, id1 = nid1; const float g0 = ng0, g1 = ng1;
    {
      const size_t tn = t0 + wv * 16 + min(tt + 1, 15);
      const u32x4* hrow = (const u32x4*)(WSP(u16, hb) + tn * 1024);
      nh0 = hrow[lane * 2]; nh1 = hrow[lane * 2 + 1];
      nid0 = WSP(int, pidx)[tn * 128 + lane]; nid1 = WSP(int, pidx)[tn * 128 + 64 + lane];
      ng0 = WSP(float, pgate)[tn * 128 + lane]; ng1 = WSP(float, pgate)[tn * 128 + 64 + lane];
    }
    float xf[16]; unpack8(ch0, xf); unpack8(ch1, xf + 8);
    float xm = 0.f;
#pragma unroll
    for (int i = 0; i < 16; ++i) xm = fmaxf(xm, fabsf(xf[i]));
#pragma unroll
    for (int o = 32; o > 0; o >>= 1) xm = fmaxf(xm, __shfl_xor(xm, o));
    xm = fmaxf(xm, 1e-30f);
    const float xinv = 127.f / xm;
    const float sxrs = xm * (1.f / 127.f) * rs;
    int xq[4];
#pragma unroll
    for (int i = 0; i < 4; ++i) {
      unsigned b0 = (unsigned)(int)rintf(xf[4 * i] * xinv) & 0xffu, b1 = (unsigned)(int)rintf(xf[4 * i + 1] * xinv) & 0xffu;
      unsigned b2 = (unsigned)(int)rintf(xf[4 * i + 2] * xinv) & 0xffu, b3 = (unsigned)(int)rintf(xf[4 * i + 3] * xinv) & 0xffu;
      xq[i] = (int)(b0 | (b1 << 8) | (b2 << 16) | (b3 << 24));
    }
    float acc[16];
#pragma unroll
    for (int i = 0; i < 16; ++i) acc[i] = 0.f;
    float corr = 0.f;
    u32x4 ua[4], va[4]; float gt[4], su[4], sv[4];
    u32x4 nua[4], nva[4]; float ngt[4], nsu[4], nsv[4];
#pragma unroll
    for (int j = 0; j < 4; ++j) {
      const int e = __builtin_amdgcn_readlane(id0, j);
      gt[j] = __uint_as_float(__builtin_amdgcn_readlane(__float_as_uint(g0), j));
      ua[j] = ((const u32x4*)(p.ws + OFF_ub))[(size_t)e * 128 + lane];
      va[j] = ((const u32x4*)(p.ws + OFF_ub))[(size_t)e * 128 + 64 + lane];
      su[j] = WSP(float, us)[e]; sv[j] = WSP(float, vs)[e];
    }
    for (int k0 = 0; k0 < 128; k0 += 4) {
      {
        const int kn = min(k0 + 4, 124);
        const int ids = (kn < 64) ? id0 : id1; const float gs = (kn < 64) ? g0 : g1;
#pragma unroll
        for (int j = 0; j < 4; ++j) {
          const int e = __builtin_amdgcn_readlane(ids, (kn + j) & 63);
          ngt[j] = __uint_as_float(__builtin_amdgcn_readlane(__float_as_uint(gs), (kn + j) & 63));
          nua[j] = ((const u32x4*)(p.ws + OFF_ub))[(size_t)e * 128 + lane];
          nva[j] = ((const u32x4*)(p.ws + OFF_ub))[(size_t)e * 128 + 64 + lane];
          nsu[j] = WSP(float, us)[e]; nsv[j] = WSP(float, vs)[e];
        }
      }
      int d[4];
#pragma unroll
      for (int j = 0; j < 4; ++j) {
        int a = 0;
#pragma unroll
        for (int i = 0; i < 4; ++i) a = __builtin_amdgcn_sdot4((int)ua[j][i], xq[i], a, false);
        d[j] = a;
      }
      const bool b0 = lane & 1, b1 = lane & 2;
      int k0v = b0 ? d[1] : d[0], s0v = b0 ? d[0] : d[1];
      int k1v = b0 ? d[3] : d[2], s1v = b0 ? d[2] : d[3];
      k0v += __shfl_xor(s0v, 1); k1v += __shfl_xor(s1v, 1);
      int kv = b1 ? k1v : k0v, sv2 = b1 ? k0v : k1v;
      kv += __shfl_xor(sv2, 2);
      kv += __shfl_xor(kv, 4); kv += __shfl_xor(kv, 8); kv += __shfl_xor(kv, 16); kv += __shfl_xor(kv, 32);
      const int jm = lane & 3;
      const float su_l = (jm == 0) ? su[0] : (jm == 1) ? su[1] : (jm == 2) ? su[2] : su[3];
      const float sv_l = (jm == 0) ? sv[0] : (jm == 1) ? sv[1] : (jm == 2) ? sv[2] : sv[3];
      const float gt_l = (jm == 0) ? gt[0] : (jm == 1) ? gt[1] : (jm == 2) ? gt[2] : gt[3];
      const float pre = (float)kv * su_l * sxrs;
      const float a_l = 0.5f * pre * (1.f + erff(pre * 0.70710678118654752f)) * gt_l * sv_l;
#pragma unroll
      for (int j = 0; j < 4; ++j) {
        const float a = __uint_as_float(__builtin_amdgcn_readlane(__float_as_uint(a_l), j));
        corr += a;
#pragma unroll
        for (int i = 0; i < 4; ++i) {
          const unsigned wd = va[j][i];
          acc[4 * i] += a * (float)(wd & 0xffu); acc[4 * i + 1] += a * (float)((wd >> 8) & 0xffu);
          acc[4 * i + 2] += a * (float)((wd >> 16) & 0xffu); acc[4 * i + 3] += a * (float)(wd >> 24);
        }
      }
#pragma unroll
      for (int j = 0; j < 4; ++j) { ua[j] = nua[j]; va[j] = nva[j]; gt[j] = ngt[j]; su[j] = nsu[j]; sv[j] = nsv[j]; }
    }
    const float c128 = 128.f * corr;
    float hf[16]; unpack8(ch0, hf); unpack8(ch1, hf + 8);
    f32x4* orow = (f32x4*)(p.out + t * 1024) + lane * 4;
#pragma unroll
    for (int i = 0; i < 4; ++i)
      orow[i] = mkf4(hf[4 * i] + acc[4 * i] - c128, hf[4 * i + 1] + acc[4 * i + 1] - c128, hf[4 * i + 2] + acc[4 * i + 2] - c128,
                     hf[4 * i + 3] + acc[4 * i + 3] - c128);
  }
}

DI void grid_barrier(unsigned* ctr, unsigned target) {
  __syncthreads();
  if (threadIdx.x == 0) {
    __builtin_amdgcn_fence(__ATOMIC_RELEASE, "agent");
    asm volatile("s_waitcnt vmcnt(0)" ::: "memory");
    __hip_atomic_fetch_add(ctr, 1u, __ATOMIC_RELAXED, __HIP_MEMORY_SCOPE_AGENT);
    while (__hip_atomic_load(ctr, __ATOMIC_RELAXED, __HIP_MEMORY_SCOPE_AGENT) < target) __builtin_amdgcn_s_sleep(2);
    __builtin_amdgcn_fence(__ATOMIC_ACQUIRE, "agent");
    asm volatile("s_waitcnt vmcnt(0)" ::: "memory");
  }
  __syncthreads();
}

#ifndef NOMAIN
__global__ void __launch_bounds__(256, 2) hybrid_megakernel(Params p) {
  __shared__ __attribute__((aligned(16))) char smem[SMEM_BYTES];
  cg::grid_group grid = cg::this_grid();
  unsigned* bar = (unsigned*)(p.ws + OFF_bar);
  if (blockIdx.x == 0 && threadIdx.x == 0) __hip_atomic_store(bar, 0u, __ATOMIC_RELAXED, __HIP_MEMORY_SCOPE_AGENT);
  phase0(p, smem);
  grid.sync();
  phase1(p, smem);
  grid_barrier(bar, gridDim.x);
  for (int item = blockIdx.x; item < 512; item += gridDim.x) attn_item(p, item, smem);
  for (int item = blockIdx.x; item < 4096; item += gridDim.x) dn_chunk_item(p, item, smem);
  grid_barrier(bar, 2 * gridDim.x);
  for (int item = blockIdx.x; item < 512; item += gridDim.x) dn_scan_item(p, item, smem);
  grid_barrier(bar, 3 * gridDim.x);
  for (int tile = blockIdx.x; tile < 512; tile += gridDim.x) p4_gemm2(p, tile, smem);
  __syncthreads();
  for (int tile = blockIdx.x; tile < 512; tile += gridDim.x) p4_gemm3(p, tile, smem);
  __syncthreads();
  for (int tile = blockIdx.x; tile < 512; tile += gridDim.x) { p4_peer(p, 2 * tile, smem); p4_peer(p, 2 * tile + 1, smem); }
}

extern "C" void kernel_launch(void* const* d_in, const int* in_sizes, int n_in, void* d_out, int out_size, void* d_ws, size_t ws_size,
                              hipStream_t stream) {
  static int grid_blocks = 0;
  if (!grid_blocks) {
    int dev = 0, cus = 0, per_cu = 0;
    hipGetDevice(&dev);
    hipDeviceGetAttribute(&cus, hipDeviceAttributeMultiprocessorCount, dev);
    hipOccupancyMaxActiveBlocksPerMultiprocessor(&per_cu, hybrid_megakernel, 256, 0);
    if (per_cu > 2) per_cu = 2;
    grid_blocks = cus * per_cu;
  }
  Params p{};
  p.x = (const float*)d_in[0]; p.g1 = (const float*)d_in[1]; p.w_in = (const float*)d_in[2]; p.gq = (const float*)d_in[3];
  p.gk = (const float*)d_in[4]; p.sinks = (const float*)d_in[5]; p.g_att = (const float*)d_in[6]; p.convw = (const float*)d_in[7];
  p.a_log = (const float*)d_in[8]; p.dt_bias = (const float*)d_in[9]; p.g_o = (const float*)d_in[10]; p.w_out = (const float*)d_in[11];
  p.g_ffn = (const float*)d_in[12]; p.w_q = (const float*)d_in[13]; p.keys = (const float*)d_in[14]; p.pu = (const float*)d_in[15];
  p.pv = (const float*)d_in[16];
  p.out = (float*)d_out;
  p.ws = (char*)d_ws;
  if (WS_TOTAL > ws_size) { fprintf(stderr, "workspace too small: need %zu have %zu\n", (size_t)WS_TOTAL, ws_size); return; }
  void* args[] = {&p};
  hipError_t e = hipLaunchCooperativeKernel((void*)hybrid_megakernel, dim3(grid_blocks), dim3(256), args, 0, stream);
  if (e != hipSuccess) fprintf(stderr, "cooperative launch failed: %s (grid %d)\n", hipGetErrorString(e), grid_blocks);
}
#endif
```
